# Optimizing an MI355X kernel written in HIP

```python
import math
import jax, jax.numpy as jnp
from jax import lax
import numpy as np

D_MODEL = 2048
BATCH = 4
SEQ = 2048
DEPTH = 2

N_EVEN = (DEPTH + 1) // 2
N_ODD = DEPTH // 2
EPS = 1e-6

A_HEADS = 8
A_QK_DIM = 64
A_V_DIM = 2 * A_QK_DIM
A_QK_WIDTH = A_HEADS * 2 * A_QK_DIM
A_WIDTH = A_HEADS * A_V_DIM
ROPE_THETA = 500000.0
ROPE_DIM = A_QK_DIM // 4
Q_BLOCK = 128

B_GROUPS = 8
B_GROUP_DIM = 128
B_WIDTH = B_GROUPS * B_GROUP_DIM
B_CHUNK = 128

EVEN_IN = 2 * A_QK_WIDTH + A_WIDTH + 2 * B_WIDTH
EVEN_OUT = A_WIDTH + B_WIDTH

C_EXPAND = 128
C_HEADS = D_MODEL // C_EXPAND
C_DK = C_EXPAND
C_DV = D_MODEL // C_HEADS
C_WIDTH = C_HEADS * C_DK
C_CHUNK = 64
ODD_IN = 5 * C_WIDTH

FFN_HIDDEN = ((8 * D_MODEL // 3 + 255) // 256) * 256

kernel_name = "hybrid_diffattn_gmlp_hgrn2_encoder"


def rms_norm(x, g):
    xf = x.astype(jnp.float32)
    y = xf * lax.rsqrt(jnp.mean(xf * xf, axis=-1, keepdims=True) + EPS)
    return (y * g.astype(jnp.float32)).astype(x.dtype)


def layer_norm(x, g, b):
    xf = x.astype(jnp.float32)
    mu = jnp.mean(xf, axis=-1, keepdims=True)
    xc = xf - mu
    var = jnp.mean(xc * xc, axis=-1, keepdims=True)
    y = xc * lax.rsqrt(var + EPS) * g.astype(jnp.float32) + b.astype(jnp.float32)
    return y.astype(x.dtype)


def partial_rope(x, pos):
    half = ROPE_DIM // 2
    inv_freq = ROPE_THETA ** (-jnp.arange(half, dtype=jnp.float32) / half)
    ang = pos[:, None] * inv_freq[None, :]
    cos = jnp.cos(ang).astype(x.dtype)
    sin = jnp.sin(ang).astype(x.dtype)
    x1 = x[..., :half]
    x2 = x[..., half:ROPE_DIM]
    rest = x[..., ROPE_DIM:]
    return jnp.concatenate([x1 * cos - x2 * sin, x2 * cos + x1 * sin, rest], axis=-1)


def diff_attention(q, k, v, lam, pos):
    B, S = q.shape[0], q.shape[1]
    q = partial_rope(jnp.einsum('bshcd->bhcsd', q), pos)
    k = partial_rope(jnp.einsum('bshcd->bhcsd', k), pos)
    v = jnp.einsum('bshd->bhsd', v)
    scale = A_QK_DIM ** -0.5
    nb = S // Q_BLOCK
    qb = jnp.moveaxis(q.reshape(B, A_HEADS, 2, nb, Q_BLOCK, A_QK_DIM), 3, 0)

    def block(qi):
        s = jnp.einsum('bhcqd,bhckd->bhcqk', qi, k).astype(jnp.float32) * scale
        p = jax.nn.softmax(s, axis=-1)
        a = p[:, :, 0] - lam * p[:, :, 1]
        return jnp.einsum('bhqk,bhkd->bhqd', a.astype(v.dtype), v)

    o = lax.map(block, qb)
    return jnp.transpose(o, (1, 0, 3, 2, 4)).reshape(B, S, A_HEADS, A_V_DIM)


def even_mixer(h, w_in, w_out, lq1, lk1, lq2, lk2, subln, ln_g, ln_b, w_s, b_s,
               layer_idx, pos):
    B, S, _ = h.shape
    proj = h @ w_in
    s1 = A_QK_WIDTH
    s2 = 2 * A_QK_WIDTH
    s3 = s2 + A_WIDTH
    s4 = s3 + B_WIDTH
    q, k, va, u, vb = jnp.split(proj, [s1, s2, s3, s4], axis=-1)

    q = q.reshape(B, S, A_HEADS, 2, A_QK_DIM)
    k = k.reshape(B, S, A_HEADS, 2, A_QK_DIM)
    va = va.reshape(B, S, A_HEADS, A_V_DIM)
    lam_init = 0.8 - 0.6 * math.exp(-0.3 * layer_idx)
    lam = (jnp.exp(jnp.sum(lq1.astype(jnp.float32) * lk1.astype(jnp.float32)))
           - jnp.exp(jnp.sum(lq2.astype(jnp.float32) * lk2.astype(jnp.float32)))
           + lam_init)
    oa = diff_attention(q, k, va, lam, pos)
    oa = (rms_norm(oa, subln) * (1.0 - lam_init)).reshape(B, S, A_WIDTH)

    u = jax.nn.gelu(u)
    vb = layer_norm(jax.nn.gelu(vb), ln_g, ln_b)
    nc = S // B_CHUNK
    vb = vb.reshape(B, nc, B_CHUNK, B_GROUPS, B_GROUP_DIM)
    sv = jnp.einsum('gpq,bnqgc->bnpgc', w_s, vb) + jnp.transpose(b_s)[None, None, :, :, None]
    ob = u * sv.reshape(B, S, B_WIDTH)

    return jnp.concatenate([oa, ob], axis=-1) @ w_out


def hgrn2_scan(q, k, v, logf):
    D2, B, H, S, dk = q.shape
    dv = v.shape[-1]
    nc = S // C_CHUNK

    def to_chunks(t):
        return jnp.moveaxis(t.reshape(D2, B, H, nc, C_CHUNK, t.shape[-1]), 3, 0)

    xs = (to_chunks(q), to_chunks(k), to_chunks(v), to_chunks(logf))
    mask = jnp.tril(jnp.ones((C_CHUNK, C_CHUNK), dtype=bool))[:, :, None]

    def step(state, inp):
        qi, ki, vi, gi = inp
        b = jnp.cumsum(gi, axis=-2)
        diff = b[..., :, None, :] - b[..., None, :, :]
        decay = jnp.exp(jnp.where(mask, diff, -jnp.inf))
        scores = jnp.einsum('...tk,...tsk->...ts', qi, decay * ki[..., None, :, :])
        o_intra = jnp.einsum('...ts,...sv->...tv', scores, vi)
        o_inter = jnp.einsum('...tk,...kv->...tv', qi * jnp.exp(b), state)
        b_last = b[..., -1:, :]
        k_dec = ki * jnp.exp(b_last - b)
        new_state = (state * jnp.exp(b_last)[..., 0, :, None]
                     + jnp.einsum('...sk,...sv->...kv', k_dec, vi))
        return new_state, o_intra + o_inter

    state0 = jnp.zeros((D2, B, H, dk, dv), jnp.float32)
    _, o = lax.scan(step, state0, xs)
    return jnp.moveaxis(o, 0, 3).reshape(D2, B, H, S, dv)


def odd_mixer(h, w_in, w_out, lower_bounds, g_norm, layer_idx):
    B, S, _ = h.shape
    proj = h @ w_in
    q, f_fwd, f_bwd, i, g = jnp.split(proj, 5, axis=-1)
    lbs = jax.nn.softmax(lower_bounds.astype(jnp.float32), axis=1)
    lb = (jnp.cumsum(lbs, axis=1) - lbs[:, :1])[:, layer_idx]
    lb = lb[:, None, None, :]
    f = lb + (1.0 - lb) * jax.nn.sigmoid(jnp.stack([f_fwd, f_bwd], 0).astype(jnp.float32))
    k = 1.0 - f
    logf = jnp.log(f)
    q = jax.nn.silu(q).astype(jnp.float32)
    i = i.astype(jnp.float32)

    def bidir(fwd, bwd):
        return jnp.stack([fwd, jnp.flip(bwd, axis=1)], axis=0)

    def heads(t, d):
        return jnp.transpose(t.reshape(2, B, S, C_HEADS, d), (0, 1, 3, 2, 4))

    o = hgrn2_scan(heads(bidir(q, q), C_DK), heads(bidir(k[0], k[1]), C_DK),
                   heads(bidir(i, i), C_DV), heads(bidir(logf[0], logf[1]), C_DK))
    o = o[0] + jnp.flip(o[1], axis=2)
    o = jnp.transpose(o, (0, 2, 1, 3)).reshape(B, S, C_HEADS * C_DV).astype(h.dtype)
    o = rms_norm(o, g_norm) * jax.nn.silu(g)
    return o @ w_out


def swiglu(h, w_gate, w_up, w_down):
    return (jax.nn.silu(h @ w_gate) * (h @ w_up)) @ w_down


def setup_inputs(seed: int = 0) -> dict:
    key = jax.random.key(seed)
    ks = jax.random.split(key, 24)
    f32 = jnp.float32

    def nrm(k, shape, scale):
        return jax.random.normal(k, shape, f32) * scale

    def gain(k, shape):
        return 1.0 + 0.02 * jax.random.normal(k, shape, f32)

    return {
        "x": jax.random.normal(ks[0], (BATCH, SEQ, D_MODEL), f32),
        "mix_norm": gain(ks[1], (DEPTH, D_MODEL)),
        "even_w_in": nrm(ks[2], (N_EVEN, D_MODEL, EVEN_IN), D_MODEL ** -0.5),
        "even_w_out": nrm(ks[3], (N_EVEN, EVEN_OUT, D_MODEL), EVEN_OUT ** -0.5),
        "diff_lq1": nrm(ks[4], (N_EVEN, A_QK_DIM), 0.1),
        "diff_lk1": nrm(ks[5], (N_EVEN, A_QK_DIM), 0.1),
        "diff_lq2": nrm(ks[6], (N_EVEN, A_QK_DIM), 0.1),
        "diff_lk2": nrm(ks[7], (N_EVEN, A_QK_DIM), 0.1),
        "diff_subln": gain(ks[8], (N_EVEN, A_V_DIM)),
        "gmlp_ln_g": gain(ks[9], (N_EVEN, B_WIDTH)),
        "gmlp_ln_b": nrm(ks[10], (N_EVEN, B_WIDTH), 0.02),
        "gmlp_w_s": nrm(ks[11], (N_EVEN, B_GROUPS, B_CHUNK, B_CHUNK), B_CHUNK ** -0.5),
        "gmlp_b_s": gain(ks[12], (N_EVEN, B_GROUPS, B_CHUNK)),
        "hgrn_w_in": nrm(ks[13], (N_ODD, D_MODEL, ODD_IN), D_MODEL ** -0.5),
        "hgrn_w_out": nrm(ks[14], (N_ODD, C_WIDTH, D_MODEL), C_WIDTH ** -0.5),
        "hgrn_lower_bounds": nrm(ks[15], (2, DEPTH, C_WIDTH), 0.1),
        "hgrn_g_norm": gain(ks[16], (N_ODD, C_WIDTH)),
        "ffn_norm": gain(ks[17], (DEPTH, D_MODEL)),
        "ffn_w_gate": nrm(ks[18], (DEPTH, D_MODEL, FFN_HIDDEN), D_MODEL ** -0.5),
        "ffn_w_up": nrm(ks[19], (DEPTH, D_MODEL, FFN_HIDDEN), D_MODEL ** -0.5),
        "ffn_w_down": nrm(ks[20], (DEPTH, FFN_HIDDEN, D_MODEL), FFN_HIDDEN ** -0.5),
        "final_norm": gain(ks[21], (D_MODEL,)),
    }


def reference(x, mix_norm, even_w_in, even_w_out, diff_lq1, diff_lk1, diff_lq2,
              diff_lk2, diff_subln, gmlp_ln_g, gmlp_ln_b, gmlp_w_s, gmlp_b_s,
              hgrn_w_in, hgrn_w_out, hgrn_lower_bounds, hgrn_g_norm, ffn_norm,
              ffn_w_gate, ffn_w_up, ffn_w_down, final_norm):
    S = x.shape[1]
    pos = jnp.arange(S, dtype=jnp.float32)
    h = x
    for l in range(DEPTH):
        hn = rms_norm(h, mix_norm[l])
        if l % 2 == 0:
            e = l // 2
            h = h + even_mixer(hn, even_w_in[e], even_w_out[e], diff_lq1[e], diff_lk1[e],
                               diff_lq2[e], diff_lk2[e], diff_subln[e], gmlp_ln_g[e],
                               gmlp_ln_b[e], gmlp_w_s[e], gmlp_b_s[e], l, pos)
        else:
            o = l // 2
            h = h + odd_mixer(hn, hgrn_w_in[o], hgrn_w_out[o], hgrn_lower_bounds,
                              hgrn_g_norm[o], l)
        hn = rms_norm(h, ffn_norm[l])
        h = h + swiglu(hn, ffn_w_gate[l], ffn_w_up[l], ffn_w_down[l])
    return rms_norm(h, final_norm)
```

```cpp
#include <hip/hip_runtime.h>
#include <hip/hip_cooperative_groups.h>
#include <cstdio>
namespace cg = cooperative_groups;

#define DI __device__ __forceinline__
#define LAS __attribute__((address_space(3)))
typedef unsigned short bf16_t;
typedef short bf16x8 __attribute__((ext_vector_type(8)));
typedef float f32x2 __attribute__((ext_vector_type(2)));
typedef float f32x4 __attribute__((ext_vector_type(4)));
typedef float f32x16 __attribute__((ext_vector_type(16)));
typedef unsigned u32x2 __attribute__((ext_vector_type(2)));
typedef unsigned u32x4 __attribute__((ext_vector_type(4)));
typedef __bf16 bf16x2_t __attribute__((ext_vector_type(2)));

constexpr int MROWS = 8192, DM = 2048, SEQ = 2048, FFN = 5632;
constexpr int LDS_BYTES = 156160;
constexpr float EPS = 1e-6f;
constexpr float QSCALE = 0.125f * 1.4426950408889634f;

constexpr size_t SZ_IN0 = (size_t)5120 * 2048 * 2, SZ_OUT = (size_t)2048 * 2048 * 2, SZ_GU = (size_t)11264 * 2048 * 2, SZ_DN = (size_t)2048 * 5632 * 2, SZ_IN1 = (size_t)10240 * 2048 * 2;
constexpr size_t WS_IN0 = 0, WS_OUT0 = WS_IN0 + SZ_IN0, WS_GU0 = WS_OUT0 + SZ_OUT, WS_DN0 = WS_GU0 + SZ_GU;
constexpr size_t WS_IN1 = WS_DN0 + SZ_DN, WS_OUT1 = WS_IN1 + SZ_IN1, WS_GU1 = WS_OUT1 + SZ_OUT, WS_DN1 = WS_GU1 + SZ_GU;
constexpr size_t WS_H = WS_DN1 + SZ_DN;
constexpr size_t WS_HN = WS_H + (size_t)MROWS * DM * 4;
constexpr size_t WS_BIG = WS_HN + (size_t)MROWS * DM * 2;
constexpr size_t SZ_BIG = (size_t)MROWS * 10240 * 2;
constexpr size_t WS_TAB = WS_BIG + SZ_BIG;
constexpr size_t WS_BAR = WS_TAB + 2048 * 16 * 4 + 4096 * 4;
constexpr size_t WS_SSQ = WS_BAR + 3456 * 4 + 256;
constexpr size_t WS_LNS = WS_SSQ + 3 * 8192 * 8;
constexpr size_t WS_SSQ3 = WS_LNS + 2 * 8192 * 8;
constexpr size_t WS_CNT = WS_SSQ3 + 8192 * 8;
constexpr size_t WS_END = WS_CNT + 32 * 64 * 4;
constexpr size_t BG_HB2 = (size_t)96 << 20;
constexpr size_t BG_QK = 0, BG_VT = BG_QK + (size_t)MROWS * 2048 * 2, BG_U = BG_VT + (size_t)MROWS * 1024 * 2, BG_GVB = BG_U + (size_t)MROWS * 1024 * 2, BG_MIX0 = BG_GVB + (size_t)MROWS * 1024 * 2;
constexpr size_t WS_O2 = WS_IN0;

struct Params {
    const float* x; const float* mix_norm; const float* even_w_in; const float* even_w_out;
    const float* lq1; const float* lk1; const float* lq2; const float* lk2; const float* subln;
    const float* ln_g; const float* ln_b; const float* w_s; const float* b_s;
    const float* hgrn_w_in; const float* hgrn_w_out; const float* lower_bounds; const float* g_norm;
    const float* ffn_norm; const float* w_gate; const float* w_up; const float* w_down; const float* final_norm;
    float* out; unsigned char* ws;
};

DI float bf2f(bf16_t b) { return __uint_as_float(((unsigned)b) << 16); }
DI unsigned pk2(float lo, float hi) { f32x2 v = {lo, hi}; bf16x2_t b = __builtin_convertvector(v, bf16x2_t); return __builtin_bit_cast(unsigned, b); }
DI bf16_t f2bf(float f) { return (bf16_t)(pk2(f, 0.f) & 0xffffu); }
DI float h2f(unsigned short b) { return (float)__builtin_bit_cast(_Float16, b); }
DI unsigned short f2h(float f) { return __builtin_bit_cast(unsigned short, (_Float16)f); }
DI float sigmoidf_(float x) { return __builtin_amdgcn_rcpf(1.f + __expf(-x)); }
DI float siluf_(float x) { return x * sigmoidf_(x); }
DI float geluf_(float x) { return x * sigmoidf_(1.5957691216057308f * (x + 0.044715f * x * x * x)); }
DI float wave_sum(float v) {
#pragma unroll
    for (int o = 32; o >= 1; o >>= 1) v += __shfl_xor(v, o);
    return v;
}
DI float xhalf_max(float v) { const auto r = __builtin_amdgcn_permlane32_swap(__float_as_uint(v), __float_as_uint(v), false, false); return fmaxf(__uint_as_float(r[0]), __uint_as_float(r[1])); }
DI float xhalf_sum(float v) { const auto r = __builtin_amdgcn_permlane32_swap(__float_as_uint(v), __float_as_uint(v), false, false); return __uint_as_float(r[0]) + __uint_as_float(r[1]); }
typedef unsigned long long u64_t;
constexpr float FX_SCALE = 1048576.f, FX_INV = 1.f / 1048576.f;
DI void fx_add(u64_t* p, float v) { atomicAdd(p, (u64_t)(long long)__float2ll_rn(v * FX_SCALE)); }
DI float fx_get(const u64_t* p) { return (float)(long long)(*p) * FX_INV; }
DI u32x4 pack8(const float* x) { u32x4 w; w.x = pk2(x[0], x[1]); w.y = pk2(x[2], x[3]); w.z = pk2(x[4], x[5]); w.w = pk2(x[6], x[7]); return w; }
DI void unpack8(u32x4 w, float* x) {
    x[0] = __uint_as_float(w.x << 16); x[1] = __uint_as_float(w.x & 0xffff0000u); x[2] = __uint_as_float(w.y << 16); x[3] = __uint_as_float(w.y & 0xffff0000u);
    x[4] = __uint_as_float(w.z << 16); x[5] = __uint_as_float(w.z & 0xffff0000u); x[6] = __uint_as_float(w.w << 16); x[7] = __uint_as_float(w.w & 0xffff0000u);
}

namespace pg8 {
constexpr int BM = 256, BK = 64, HALF = 128, HTB = HALF * BK * 2, STAGE_BYTES = 8 * HTB, NXCD = 8, WGM = 8;
DI int lds_byte(int r, int c) { const int st = (r >> 4) * 2 + (c >> 5), rr = r & 15, cc = c & 31, ob = rr * 64 + cc * 2; return st * 1024 + (ob ^ (((ob >> 9) & 1) << 5)); }
DI void stage_rc(int b, int& R, int& C) { const int st = b / 1024, sb = b % 1024, swz = sb ^ (((sb >> 9) & 1) << 5); R = (st >> 1) * 16 + swz / 64; C = (st & 1) * 32 + (swz % 64) / 2; }
DI int perm32(int rho) { const int n = rho >> 4, i = rho & 15; return 8 * (i >> 2) + 4 * n + (i & 3); }
struct Unit { int pm, pn; };
struct StaticOrder {
    int nM, nN, nwg, G, c;
    DI void init(int M, int N, int G_, int c_) { nM = M / BM; nN = N / BM; nwg = nM * nN; G = G_; c = c_; }
    DI bool next(int i, Unit& u) const {
        const long L = (long)i * G + c; if (L >= nwg) return false;
        int wgid = (int)L; { const int q = nwg / NXCD, r = nwg % NXCD, xcd = wgid % NXCD, off = wgid / NXCD; wgid = (xcd < r ? xcd * (q + 1) : r * (q + 1) + (xcd - r) * q) + off; }
        const int nig = WGM * nN, gid = wgid / nig, fm = gid * WGM, gsz = (nM - fm) < WGM ? (nM - fm) : WGM;
        u.pm = fm + ((wgid % nig) % gsz); u.pn = (wgid % nig) / gsz; return true;
    }
};

template <class Epi>
DI void gemm_phase(LAS unsigned char* lds, const bf16_t* gA, const bf16_t* gBt, int M, int N, int K, const Epi& E) {
    const int tid = threadIdx.x, wid = __builtin_amdgcn_readfirstlane(tid >> 6), lane = tid & 63, wr = wid >> 2, wc = wid & 3, fr = lane & 15, fq = lane >> 4;
    const int nt = K / BK;
    StaticOrder S; S.init(M, N, (int)gridDim.x, (int)blockIdx.x);
    unsigned voffA[2], voffB[2];
#pragma unroll
    for (int i = 0; i < 2; ++i) { int R, C; stage_rc(tid * 16 + i * 8192, R, C); const int Rb = Epi::PERM ? ((R & ~31) + perm32(R & 31)) : R;
        voffA[i] = (unsigned)(R * K + C) * 2u; voffB[i] = (unsigned)(Rb * K + C) * 2u; }
    const size_t kstep = (size_t)(BK * 2);
    const size_t hstep = (size_t)HALF * K * 2;
    const size_t tstep = 2 * hstep;
    const unsigned ldsw = (unsigned)wid * 1024u;
    const int aoff = lds_byte(wr * 64 + fr, fq * 8), boff = lds_byte(wc * 32 + fr, fq * 8);
#define PG8_SA(b, h) (((b) * 2 + (h)) * HTB)
#define PG8_SB(b, h) ((4 + (b) * 2 + (h)) * HTB)
#define PG8_STAGE(bufoff, gbase, voff) do { _Pragma("unroll") for (int _i = 0; _i < 2; ++_i) \
        __builtin_amdgcn_global_load_lds((const unsigned*)((const char*)(gbase) + (voff)[_i]), (LAS unsigned*)(lds + (bufoff) + ldsw + _i * 8192), 16, 0, 0); } while (0)
#define PG8_LDA(dst, b, h) do { _Pragma("unroll") for (int m = 0; m < 4; ++m) _Pragma("unroll") for (int k = 0; k < 2; ++k) dst[m][k] = *(const LAS bf16x8*)(lds + PG8_SA(b, h) + aoff + m * 2048 + k * 1024); } while (0)
#define PG8_LDB(dst, b, h) do { _Pragma("unroll") for (int n = 0; n < 2; ++n) _Pragma("unroll") for (int k = 0; k < 2; ++k) dst[n][k] = *(const LAS bf16x8*)(lds + PG8_SB(b, h) + boff + n * 2048 + k * 1024); } while (0)
#define PG8_MMA(ai, bj, At, Bt) do { __builtin_amdgcn_s_setprio(1); _Pragma("unroll") for (int m = 0; m < 4; ++m) _Pragma("unroll") for (int n = 0; n < 2; ++n) _Pragma("unroll") for (int k = 0; k < 2; ++k) \
        acc[ai][bj][m][n] = __builtin_amdgcn_mfma_f32_16x16x32_bf16(Bt[n][k], At[m][k], acc[ai][bj][m][n], 0, 0, 0); __builtin_amdgcn_s_setprio(0); } while (0)
#define PG8_WAIT_V(n) asm volatile("s_waitcnt vmcnt(" #n ")" ::: "memory")
#define PG8_WAIT_L(n) asm volatile("s_waitcnt lgkmcnt(" #n ")" ::: "memory")
#define PG8_BAR __builtin_amdgcn_s_barrier()
#define PG8_SCHED __builtin_amdgcn_sched_barrier(0)
    Unit cur, nxt; int ui = 0;
    if (!S.next(0, cur)) return;
    f32x4 acc[2][2][4][2];
#pragma unroll
    for (int a = 0; a < 2; ++a)
#pragma unroll
        for (int b = 0; b < 2; ++b)
#pragma unroll
            for (int m = 0; m < 4; ++m)
#pragma unroll
                for (int n = 0; n < 2; ++n) acc[a][b][m][n] = (f32x4){0.f, 0.f, 0.f, 0.f};
    bf16x8 At[4][2], B0[2][2], B1[2][2];
    const char* cA = (const char*)gA + (size_t)cur.pm * tstep; const char* cB = (const char*)gBt + (size_t)cur.pn * tstep;
    PG8_STAGE(PG8_SB(0, 0), cB, voffB); PG8_STAGE(PG8_SA(0, 0), cA, voffA); PG8_STAGE(PG8_SB(0, 1), cB + hstep, voffB); PG8_STAGE(PG8_SA(0, 1), cA + hstep, voffA);
    if (wr == 1) PG8_BAR;
    PG8_WAIT_V(4); PG8_BAR;
    PG8_STAGE(PG8_SB(1, 0), cB + kstep, voffB); PG8_STAGE(PG8_SA(1, 0), cA + kstep, voffA); PG8_STAGE(PG8_SB(1, 1), cB + hstep + kstep, voffB);
    PG8_WAIT_V(6); PG8_BAR;
    for (;;) {
        const bool has_next = S.next(ui + 1, nxt);
        const char* nA = has_next ? (const char*)gA + (size_t)nxt.pm * tstep : cA; const char* nB = has_next ? (const char*)gBt + (size_t)nxt.pn * tstep : cB;
        for (int t = 0; t < nt; t += 2) {
            const bool last = (t == nt - 2);
            const char* a1 = cA + (size_t)(t + 1) * kstep;
            const char* a2 = last ? nA : cA + (size_t)(t + 2) * kstep; const char* b2 = last ? nB : cB + (size_t)(t + 2) * kstep;
            const char* a3 = a2 + kstep; const char* b3 = b2 + kstep;
            PG8_LDB(B0, 0, 0); PG8_SCHED; PG8_LDA(At, 0, 0); PG8_STAGE(PG8_SA(1, 1), a1 + hstep, voffA);
            PG8_WAIT_L(8); PG8_BAR; PG8_WAIT_L(0); PG8_MMA(0, 0, At, B0); PG8_BAR; PG8_SCHED;
            PG8_LDB(B1, 0, 1); PG8_STAGE(PG8_SB(0, 0), b2, voffB);
            PG8_BAR; PG8_WAIT_L(0); PG8_MMA(0, 1, At, B1); PG8_BAR;
            PG8_LDA(At, 0, 1); PG8_STAGE(PG8_SA(0, 0), a2, voffA);
            PG8_BAR; PG8_WAIT_L(0); PG8_MMA(1, 0, At, B0); PG8_BAR; PG8_SCHED;
            PG8_STAGE(PG8_SB(0, 1), b2 + hstep, voffB);
            PG8_WAIT_V(6); PG8_BAR; PG8_MMA(1, 1, At, B1); PG8_BAR;
            PG8_LDB(B0, 1, 0); PG8_SCHED; PG8_LDA(At, 1, 0); PG8_STAGE(PG8_SA(0, 1), a2 + hstep, voffA);
            PG8_WAIT_L(8); PG8_BAR; PG8_WAIT_L(0); PG8_MMA(0, 0, At, B0); PG8_BAR; PG8_SCHED;
            PG8_LDB(B1, 1, 1); PG8_STAGE(PG8_SB(1, 0), b3, voffB);
            PG8_BAR; PG8_WAIT_L(0); PG8_MMA(0, 1, At, B1); PG8_BAR;
            PG8_LDA(At, 1, 1); PG8_STAGE(PG8_SA(1, 0), a3, voffA);
            PG8_BAR; PG8_WAIT_L(0); PG8_MMA(1, 0, At, B0); PG8_BAR; PG8_SCHED;
            PG8_STAGE(PG8_SB(1, 1), b3 + hstep, voffB);
            PG8_WAIT_V(6); PG8_BAR; PG8_MMA(1, 1, At, B1); PG8_BAR;
        }
        if constexpr (!Epi::AFTER_DRAIN) E(acc, cur, wr, wc, fr, fq);
        if (!has_next) break;
#pragma unroll
        for (int a = 0; a < 2; ++a)
#pragma unroll
            for (int b = 0; b < 2; ++b)
#pragma unroll
                for (int m = 0; m < 4; ++m)
#pragma unroll
                    for (int n = 0; n < 2; ++n) acc[a][b][m][n] = (f32x4){0.f, 0.f, 0.f, 0.f};
        cur = nxt; cA = nA; cB = nB; ++ui;
    }
    PG8_WAIT_V(0);
    if (wr == 0) PG8_BAR;
    PG8_BAR;
    if constexpr (Epi::AFTER_DRAIN) E(acc, cur, wr, wc, fr, fq);
#undef PG8_SA
#undef PG8_SB
#undef PG8_STAGE
#undef PG8_LDA
#undef PG8_LDB
#undef PG8_MMA
#undef PG8_WAIT_V
#undef PG8_WAIT_L
#undef PG8_BAR
#undef PG8_SCHED
}
}

struct EpiIn0 {
    static constexpr bool PERM = true, AFTER_DRAIN = false;
    bf16_t* qk; bf16_t* vT; bf16_t* ub; bf16_t* gvb; const float* rope; u64_t* lns;
    DI void operator()(const f32x4 (&acc)[2][2][4][2], const pg8::Unit& u, int wr, int wc, int fr, int fq) const {
        const int pn = u.pn;
        const int cin = (32 * wc + 8 * fq) & 63;
        const bool ropel = (pn < 8) && (cin < 16);
#pragma unroll
        for (int ai = 0; ai < 2; ++ai) {
            f32x4 rc[1][4][2];
#pragma unroll
            for (int m = 0; m < 4; ++m) {
                const int s = (u.pm * 256 + ai * 128 + wr * 64 + m * 16 + fr) & 2047;
                const float* rp = rope + (s * 8 + (cin >> 1)) * 2;
                if (ropel) { rc[0][m][0] = *(const f32x4*)rp; rc[0][m][1] = *(const f32x4*)(rp + 4); }
                else { rc[0][m][0] = (f32x4){1.f, 0.f, 1.f, 0.f}; rc[0][m][1] = (f32x4){1.f, 0.f, 1.f, 0.f}; }
            }
#pragma unroll
            for (int m = 0; m < 4; ++m) {
                const int row = u.pm * 256 + ai * 128 + wr * 64 + m * 16 + fr, s = row & 2047, b = row >> 11;
                float s1 = 0.f, s2 = 0.f;
#pragma unroll
                for (int bj = 0; bj < 2; ++bj) {
                    const int col0 = pn * 256 + bj * 128 + wc * 32 + fq * 8;
                    float x[8];
#pragma unroll
                    for (int j = 0; j < 4; ++j) { x[j] = acc[ai][bj][m][0][j]; x[4 + j] = acc[ai][bj][m][1][j]; }
                    if (pn < 8) {
                        if (ropel) {
#pragma unroll
                            for (int pp = 0; pp < 4; ++pp) { const float cs = rc[0][m][pp >> 1][2 * (pp & 1)], sn = rc[0][m][pp >> 1][2 * (pp & 1) + 1], x1 = x[2 * pp], x2 = x[2 * pp + 1]; x[2 * pp] = x1 * cs - x2 * sn; x[2 * pp + 1] = x2 * cs + x1 * sn; }
                        }
                        if (pn < 4) {
#pragma unroll
                            for (int j = 0; j < 8; ++j) x[j] *= QSCALE;
                        }
                        *(u32x4*)(qk + (size_t)row * 2048 + col0) = pack8(x);
                    } else if (pn < 12) {
                        const int col = col0 - 2048, hd = col >> 7, d = col & 127;
                        bf16_t* dst = vT + ((size_t)((b * 8 + hd) * 128 + d)) * 2048 + s;
#pragma unroll
                        for (int j = 0; j < 8; ++j) dst[(size_t)j * 2048] = f2bf(x[j]);
                    } else {
#pragma unroll
                        for (int j = 0; j < 8; ++j) { x[j] = geluf_(x[j]); s1 += x[j]; s2 += x[j] * x[j]; }
                        bf16_t* dst = (pn < 16) ? (ub + (size_t)row * 1024 + (col0 - 3072)) : (gvb + (size_t)row * 1024 + (col0 - 4096));
                        *(u32x4*)dst = pack8(x);
                    }
                }
                if (pn >= 16) {
                    s1 += __shfl_xor(s1, 16); s1 += __shfl_xor(s1, 32); s2 += __shfl_xor(s2, 16); s2 += __shfl_xor(s2, 32);
                    if (fq == 0) { fx_add(lns + 2 * row, s1); fx_add(lns + 2 * row + 1, s2); }
                }
            }
        }
    }
};
struct EpiResB {
    static constexpr bool PERM = true, AFTER_DRAIN = false;
    const bf16_t* res; float* out;
    DI void operator()(const f32x4 (&acc)[2][2][4][2], const pg8::Unit& u, int wr, int wc, int fr, int fq) const {
        const int row0 = u.pm * 256 + wr * 64 + fr, col0 = u.pn * 256 + wc * 32 + 8 * fq;
#pragma unroll
        for (int ai = 0; ai < 2; ++ai)
#pragma unroll
            for (int m = 0; m < 4; ++m)
#pragma unroll
                for (int bj = 0; bj < 2; ++bj) {
                    const size_t ro = (size_t)(row0 + ai * 128 + m * 16) * 2048 + col0 + bj * 128;
                    float t[8]; unpack8(*(const u32x4*)(res + ro), t);
                    *(f32x4*)(out + ro) = acc[ai][bj][m][0] + (f32x4){t[0], t[1], t[2], t[3]}; *(f32x4*)(out + ro + 4) = acc[ai][bj][m][1] + (f32x4){t[4], t[5], t[6], t[7]};
                }
    }
};
template <bool RES_F32>
struct EpiResN {
    static constexpr bool PERM = true, AFTER_DRAIN = false;
    const void* res; bf16_t* hb; u64_t* ssq;
    DI void operator()(const f32x4 (&acc)[2][2][4][2], const pg8::Unit& u, int wr, int wc, int fr, int fq) const {
        const int row0 = u.pm * 256 + wr * 64 + fr, col0 = u.pn * 256 + wc * 32 + 8 * fq;
#pragma unroll
        for (int ai = 0; ai < 2; ++ai) {
            f32x4 r[4][2][2];
#pragma unroll
            for (int m = 0; m < 4; ++m)
#pragma unroll
                for (int bj = 0; bj < 2; ++bj) {
                    const size_t ro = (size_t)(row0 + ai * 128 + m * 16) * 2048 + col0 + bj * 128;
                    if (RES_F32) { const float* rp = (const float*)res + ro; r[m][bj][0] = *(const f32x4*)rp; r[m][bj][1] = *(const f32x4*)(rp + 4); }
                    else { float t[8]; unpack8(*(const u32x4*)((const bf16_t*)res + ro), t); r[m][bj][0] = (f32x4){t[0], t[1], t[2], t[3]}; r[m][bj][1] = (f32x4){t[4], t[5], t[6], t[7]}; }
                }
#pragma unroll
            for (int m = 0; m < 4; ++m) {
                const int row = row0 + ai * 128 + m * 16; const size_t ro = (size_t)row * 2048 + col0;
                float ss = 0.f;
#pragma unroll
                for (int bj = 0; bj < 2; ++bj) {
                    const f32x4 v0 = acc[ai][bj][m][0] + r[m][bj][0], v1 = acc[ai][bj][m][1] + r[m][bj][1];
                    u32x4 w; w.x = pk2(v0[0], v0[1]); w.y = pk2(v0[2], v0[3]); w.z = pk2(v1[0], v1[1]); w.w = pk2(v1[2], v1[3]);
                    *(u32x4*)(hb + ro + bj * 128) = w;
                    ss += v0[0] * v0[0] + v0[1] * v0[1] + v0[2] * v0[2] + v0[3] * v0[3] + v1[0] * v1[0] + v1[1] * v1[1] + v1[2] * v1[2] + v1[3] * v1[3];
                }
                ss += __shfl_xor(ss, 16); ss += __shfl_xor(ss, 32);
                if (fq == 0) fx_add(ssq + row, ss);
            }
        }
    }
};
struct EpiFinal {
    static constexpr bool PERM = true, AFTER_DRAIN = true;
    const bf16_t* res; float* out; const float* g; u64_t* ssq; unsigned* cnt;
    DI void operator()(const f32x4 (&acc)[2][2][4][2], const pg8::Unit& u, int wr, int wc, int fr, int fq) const {
        const int row0 = u.pm * 256 + wr * 64 + fr, col0 = u.pn * 256 + wc * 32 + 8 * fq;
        f32x4 v[2][4][2][2];
#pragma unroll
        for (int ai = 0; ai < 2; ++ai) {
            f32x4 r[4][2][2];
#pragma unroll
            for (int m = 0; m < 4; ++m)
#pragma unroll
                for (int bj = 0; bj < 2; ++bj) { float t[8]; unpack8(*(const u32x4*)(res + (size_t)(row0 + ai * 128 + m * 16) * 2048 + col0 + bj * 128), t); r[m][bj][0] = (f32x4){t[0], t[1], t[2], t[3]}; r[m][bj][1] = (f32x4){t[4], t[5], t[6], t[7]}; }
#pragma unroll
            for (int m = 0; m < 4; ++m) {
                float ss = 0.f;
#pragma unroll
                for (int bj = 0; bj < 2; ++bj)
#pragma unroll
                    for (int n = 0; n < 2; ++n) { const f32x4 t = acc[ai][bj][m][n] + r[m][bj][n]; v[ai][m][bj][n] = t; ss += t[0] * t[0] + t[1] * t[1] + t[2] * t[2] + t[3] * t[3]; }
                ss += __shfl_xor(ss, 16); ss += __shfl_xor(ss, 32);
                if (fq == 0) fx_add(ssq + row0 + ai * 128 + m * 16, ss);
            }
        }
        asm volatile("s_waitcnt vmcnt(0)" ::: "memory");
        __syncthreads();
        unsigned* c = cnt + 64 * u.pm;
        if (threadIdx.x == 0) {
            __hip_atomic_fetch_add(c, 1u, __ATOMIC_RELAXED, __HIP_MEMORY_SCOPE_AGENT);
            unsigned spins = 0;
            while (__hip_atomic_load(c, __ATOMIC_RELAXED, __HIP_MEMORY_SCOPE_AGENT) < 8u) { __builtin_amdgcn_s_sleep(4); if (++spins > (1u << 21)) break; }
        }
        __syncthreads();
        __builtin_amdgcn_fence(__ATOMIC_ACQUIRE, "agent");
        f32x4 gv[2][2];
#pragma unroll
        for (int bj = 0; bj < 2; ++bj) { gv[bj][0] = *(const f32x4*)(g + col0 + bj * 128); gv[bj][1] = *(const f32x4*)(g + col0 + bj * 128 + 4); }
#pragma unroll
        for (int ai = 0; ai < 2; ++ai)
#pragma unroll
            for (int m = 0; m < 4; ++m) {
                const int row = row0 + ai * 128 + m * 16;
                const float rs = rsqrtf((float)(long long)__hip_atomic_load(ssq + row, __ATOMIC_RELAXED, __HIP_MEMORY_SCOPE_AGENT) * FX_INV * (1.f / DM) + EPS);
#pragma unroll
                for (int bj = 0; bj < 2; ++bj)
#pragma unroll
                    for (int n = 0; n < 2; ++n) *(f32x4*)(out + (size_t)row * 2048 + col0 + bj * 128 + 4 * n) = v[ai][m][bj][n] * rs * gv[bj][n];
            }
    }
};
struct EpiGU {
    static constexpr bool PERM = true, AFTER_DRAIN = false;
    bf16_t* act; const u64_t* ssq;
    DI void operator()(const f32x4 (&acc)[2][2][4][2], const pg8::Unit& u, int wr, int wc, int fr, int fq) const {
        const int row0 = u.pm * 256 + wr * 64 + fr, col0 = u.pn * 128 + wc * 32 + 8 * fq;
        float rs[2][4];
#pragma unroll
        for (int ai = 0; ai < 2; ++ai)
#pragma unroll
            for (int m = 0; m < 4; ++m) rs[ai][m] = fx_get(ssq + row0 + ai * 128 + m * 16);
#pragma unroll
        for (int ai = 0; ai < 2; ++ai)
#pragma unroll
            for (int m = 0; m < 4; ++m) {
                float x[8];
                const float r = rsqrtf(rs[ai][m] * (1.f / DM) + EPS);
#pragma unroll
                for (int j = 0; j < 4; ++j) { x[j] = siluf_(acc[ai][0][m][0][j] * r) * (acc[ai][1][m][0][j] * r); x[4 + j] = siluf_(acc[ai][0][m][1][j] * r) * (acc[ai][1][m][1][j] * r); }
                *(u32x4*)(act + (size_t)(row0 + ai * 128 + m * 16) * FFN + col0) = pack8(x);
            }
    }
};
DI int in1_tile(int p) { return p < 8 ? p + 8 : p < 16 ? p - 8 : p < 20 ? p + 8 : p < 28 ? p - 4 : p < 36 ? p + 4 : p - 8; }
struct EpiIn1 {
    static constexpr bool PERM = true, AFTER_DRAIN = false;
    unsigned short* proj; const float* lbtab; const u64_t* ssq;
    DI void operator()(const f32x4 (&acc)[2][2][4][2], const pg8::Unit& u, int wr, int wc, int fr, int fq) const {
        const int pn = in1_tile(u.pn);
        const bool gate = (pn >= 8 && pn < 24);
        float rs[2][4]; f32x4 lbv[2][2];
#pragma unroll
        for (int ai = 0; ai < 2; ++ai)
#pragma unroll
            for (int m = 0; m < 4; ++m) rs[ai][m] = fx_get(ssq + u.pm * 256 + ai * 128 + wr * 64 + m * 16 + fr);
#pragma unroll
        for (int bj = 0; bj < 2; ++bj) {
            const float* lb = lbtab + (gate ? (pn * 256 + bj * 128 + wc * 32 + fq * 8 - 2048) : 0);
            lbv[bj][0] = *(const f32x4*)lb; lbv[bj][1] = *(const f32x4*)(lb + 4);
        }
#pragma unroll
        for (int ai = 0; ai < 2; ++ai)
#pragma unroll
            for (int m = 0; m < 4; ++m) {
                const int row = u.pm * 256 + ai * 128 + wr * 64 + m * 16 + fr;
                const float r = rsqrtf(rs[ai][m] * (1.f / DM) + EPS);
#pragma unroll
                for (int bj = 0; bj < 2; ++bj) {
                    const int col0 = pn * 256 + bj * 128 + wc * 32 + fq * 8;
                    float x[8];
#pragma unroll
                    for (int j = 0; j < 4; ++j) { x[j] = acc[ai][bj][m][0][j] * r; x[4 + j] = acc[ai][bj][m][1][j] * r; }
                    u32x4 w;
                    if (gate) {
                        unsigned short hv[8];
#pragma unroll
                        for (int j = 0; j < 8; ++j) { const float l = lbv[bj][j >> 2][j & 3]; hv[j] = f2h(__log2f(l + (1.f - l) * sigmoidf_(x[j]))); }
                        w.x = hv[0] | ((unsigned)hv[1] << 16); w.y = hv[2] | ((unsigned)hv[3] << 16); w.z = hv[4] | ((unsigned)hv[5] << 16); w.w = hv[6] | ((unsigned)hv[7] << 16);
                    } else {
                        if (pn < 8 || pn >= 32) {
#pragma unroll
                            for (int j = 0; j < 8; ++j) x[j] = siluf_(x[j]);
                        }
                        w = pack8(x);
                    }
                    *(u32x4*)(proj + (size_t)row * 10240 + col0) = w;
                }
            }
    }
};

DI void cvt_tiles(int bid, int nb, float* tl, const float* s0, const float* s1, bf16_t* dst, int K, int Nsrc, int Ndst, int mode, const float* gk) {
    const int tid = threadIdx.x, tk = K / 64, tn = Ndst / 256, ntile = tk * tn;
    f32x4 v[8];
#define CVT_LOAD(tile_) do { const int r0_ = ((tile_) / tk) * 256, k0_ = ((tile_) % tk) * 64; \
        _Pragma("unroll") for (int i = 0; i < 8; ++i) { const int idx_ = tid + 512 * i, kk_ = k0_ + (idx_ >> 6), c4_ = idx_ & 63; const float* sp_; \
            if (mode == 2) sp_ = ((c4_ < 32) ? s0 : s1) + (size_t)kk_ * Nsrc + (r0_ >> 1) + 4 * (c4_ & 31); else sp_ = s0 + (size_t)kk_ * Nsrc + (mode == 3 ? (in1_tile(r0_ >> 8) << 8) : r0_) + 4 * c4_; \
            f32x4 x_ = __builtin_nontemporal_load((const f32x4*)sp_); if (gk) x_ *= gk[kk_]; v[i] = x_; } } while (0)
    int tile = bid;
    if (tile < ntile) CVT_LOAD(tile);
    for (; tile < ntile; tile += nb) {
#pragma unroll
        for (int i = 0; i < 8; ++i) { const int idx = tid + 512 * i; float* d = tl + (idx >> 6) * 257 + 4 * (idx & 63); d[0] = v[i][0]; d[1] = v[i][1]; d[2] = v[i][2]; d[3] = v[i][3]; }
        __syncthreads();
        if (tile + nb < ntile) CVT_LOAD(tile + nb);
        {
            const int r0 = (tile / tk) * 256, k0 = (tile % tk) * 64, kc = tid & 7;
#pragma unroll
            for (int i = 0; i < 4; ++i) {
                const int rr = (tid >> 3) + 64 * i; int col = rr;
                if (mode == 1) { const int j = rr & 63; if (r0 < 2048 && j < 16) col = (rr & ~63) + ((j & 1) ? 8 + (j >> 1) : (j >> 1)); }
                float x[8];
#pragma unroll
                for (int j = 0; j < 8; ++j) x[j] = tl[(kc * 8 + j) * 257 + col];
                __builtin_nontemporal_store(pack8(x), (u32x4*)(dst + (size_t)(r0 + rr) * K + k0 + kc * 8));
            }
        }
        __syncthreads();
    }
#undef CVT_LOAD
}
DI bool gemm_short_block(int M, int N, int& sid, int& ns) {
    const int nwg = (M / 256) * (N / 256), rem = nwg % (int)gridDim.x;
    if (rem == 0) { sid = (int)blockIdx.x; ns = (int)gridDim.x; return true; }
    if ((int)blockIdx.x < rem) return false;
    sid = (int)blockIdx.x - rem; ns = (int)gridDim.x - rem; return true;
}

template <bool OUT_BF16>
DI void rmsnorm_phase(const float* src, const float* g, void* dst, int rb, int re) {
    const int lane = threadIdx.x & 63, wid = threadIdx.x >> 6, stride = 8;
    f32x4 vA[8], vB[8];
#define RN_LOAD(v, row_) do { const f32x4* sp_ = (const f32x4*)(src + (size_t)(row_) * DM); _Pragma("unroll") for (int i = 0; i < 8; ++i) (v)[i] = sp_[lane + 64 * i]; } while (0)
#define RN_DO(v, row_) do { float ss = 0.f; _Pragma("unroll") for (int i = 0; i < 8; ++i) ss += (v)[i][0] * (v)[i][0] + (v)[i][1] * (v)[i][1] + (v)[i][2] * (v)[i][2] + (v)[i][3] * (v)[i][3]; \
        ss = wave_sum(ss); const float rstd = rsqrtf(ss * (1.f / DM) + EPS); \
        _Pragma("unroll") for (int i = 0; i < 8; ++i) { const f32x4 gv = ((const f32x4*)g)[lane + 64 * i]; const f32x4 y = (v)[i] * rstd * gv; \
            if (OUT_BF16) { u32x2 w; w.x = pk2(y[0], y[1]); w.y = pk2(y[2], y[3]); *(u32x2*)((bf16_t*)dst + (size_t)(row_) * DM + (lane + 64 * i) * 4) = w; } \
            else *(f32x4*)((float*)dst + (size_t)(row_) * DM + (lane + 64 * i) * 4) = y; } } while (0)
    int row = rb + wid;
    if (row < re) RN_LOAD(vA, row);
    for (; row < re; row += 2 * stride) {
        if (row + stride < re) RN_LOAD(vB, row + stride);
        RN_DO(vA, row);
        if (row + stride < re) {
            if (row + 2 * stride < re) RN_LOAD(vA, row + 2 * stride);
            RN_DO(vB, row + stride);
        }
    }
#undef RN_LOAD
#undef RN_DO
}

DI void phase0(const Params& p, unsigned char* smem) {
    unsigned char* ws = p.ws; float* tl = (float*)smem;
    float* rope = (float*)(ws + WS_TAB); float* lbt = rope + 2048 * 16;
    const int rbid = (int)gridDim.x - 1 - (int)blockIdx.x;
    for (int e = rbid * 512 + threadIdx.x; e < 2048 * 8; e += gridDim.x * 512) {
        const int s = e >> 3, i = e & 7; const float inv = powf(500000.f, -(float)i / 8.f); const float ang = (float)s * inv;
        rope[2 * e] = cosf(ang); rope[2 * e + 1] = sinf(ang);
    }
    for (int e = rbid * 512 + threadIdx.x; e < 4096; e += gridDim.x * 512) {
        const int d = e >> 11, w = e & 2047; const float l0 = p.lower_bounds[d * 4096 + w], l1 = p.lower_bounds[d * 4096 + 2048 + w];
        lbt[e] = 1.f / (1.f + expf(l0 - l1));
    }
    for (int e = blockIdx.x * 512 + threadIdx.x; e < 12 * 8192 + 32 * 64; e += gridDim.x * 512) ((unsigned*)(ws + WS_SSQ))[e] = 0u;
    {
        int rb, re; const int G = (int)gridDim.x, b = (int)blockIdx.x;
        if (G == 256) { if (b < 128) { rb = 28 * b; re = rb + 28; } else { rb = 3584 + 36 * (b - 128); re = rb + 36; } }
        else { rb = (int)(((long)MROWS * b) / G); re = (int)(((long)MROWS * (b + 1)) / G); }
        rmsnorm_phase<true>(p.x, p.mix_norm, ws + WS_HN, rb, re);
    }
    cvt_tiles(blockIdx.x, gridDim.x, tl, p.even_w_in, nullptr, (bf16_t*)(ws + WS_IN0), 2048, 5120, 5120, 1, nullptr);
}

#define MFMA32(a, b, c) __builtin_amdgcn_mfma_f32_32x32x16_bf16((a), (b), (c), 0, 0, 0)
constexpr int AT_KROW = 144, AT_VROW = 136, AT_KBYTES = 2 * 64 * AT_KROW, AT_STAGE = AT_KBYTES + 128 * AT_VROW;
DI void attn_item(const Params& p, unsigned char* smem, int item, float lam) {
    const int tid = threadIdx.x, lane = tid & 63, wid = tid >> 6, r = lane & 31, hh = lane >> 5;
    const int cmap = wid & 1, sub = wid >> 1;
    const int qb = item & 15, hd = (item >> 4) & 7, b = item >> 7;
    const bf16_t* qkb = (const bf16_t*)(p.ws + WS_BIG + BG_QK) + (size_t)b * 2048 * 2048;
    const bf16_t* kbase = qkb + 1024 + hd * 128;
    const bf16_t* vbase = (const bf16_t*)(p.ws + WS_BIG + BG_VT) + (size_t)((b * 8 + hd) * 128) * 2048;
    bf16x8 qf[4];
    {
        const bf16_t* qp = qkb + (size_t)(qb * 128 + sub * 32 + r) * 2048 + hd * 128 + cmap * 64 + 8 * hh;
#pragma unroll
        for (int ks = 0; ks < 4; ++ks) qf[ks] = *(const bf16x8*)(qp + 16 * ks);
    }
    f32x16 o[4];
#pragma unroll
    for (int vt = 0; vt < 4; ++vt)
#pragma unroll
        for (int i = 0; i < 16; ++i) o[vt][i] = 0.f;
    float m_run = -1e30f, l_run = 0.f;
    const int ke0 = tid, ke1 = tid + 512;
    const int kkey0 = ke0 >> 4, kpart0 = ke0 & 15, kkey1 = ke1 >> 4, kpart1 = ke1 & 15;
    const int klds0 = ((kpart0 >> 3) * 64 + kkey0) * AT_KROW + (kpart0 & 7) * 16, klds1 = ((kpart1 >> 3) * 64 + kkey1) * AT_KROW + (kpart1 & 7) * 16;
    const int vdv0 = ke0 >> 3, vpart0 = ke0 & 7, vdv1 = ke1 >> 3, vpart1 = ke1 & 7;
    const int vlds0 = AT_KBYTES + vdv0 * AT_VROW + vpart0 * 16, vlds1 = AT_KBYTES + vdv1 * AT_VROW + vpart1 * 16;
    u32x4 kr0, kr1, vr0, vr1;
#define AT_GLOAD(t) do { \
        kr0 = *(const u32x4*)(kbase + (size_t)((t) * 64 + kkey0) * 2048 + kpart0 * 8); kr1 = *(const u32x4*)(kbase + (size_t)((t) * 64 + kkey1) * 2048 + kpart1 * 8); \
        vr0 = *(const u32x4*)(vbase + (size_t)vdv0 * 2048 + (t) * 64 + vpart0 * 8); vr1 = *(const u32x4*)(vbase + (size_t)vdv1 * 2048 + (t) * 64 + vpart1 * 8); } while (0)
#define AT_LSTORE(buf) do { unsigned char* _b = smem + (buf) * AT_STAGE; \
        *(u32x4*)(_b + klds0) = kr0; *(u32x4*)(_b + klds1) = kr1; \
        *(u32x2*)(_b + vlds0) = (u32x2){vr0.x, vr0.y}; *(u32x2*)(_b + vlds0 + 8) = (u32x2){vr0.z, vr0.w}; \
        *(u32x2*)(_b + vlds1) = (u32x2){vr1.x, vr1.y}; *(u32x2*)(_b + vlds1 + 8) = (u32x2){vr1.z, vr1.w}; } while (0)
    const bool late = (__builtin_popcount((unsigned)wid) & 1) != 0;
    bf16x8 pprev[2][2];
#pragma unroll
    for (int kt = 0; kt < 2; ++kt)
#pragma unroll
        for (int s = 0; s < 2; ++s)
#pragma unroll
            for (int j = 0; j < 8; ++j) pprev[kt][s][j] = 0;
#define AT_VLOAD(dst_, Vc_, g_) do { _Pragma("unroll") for (int vt = 0; vt < 4; ++vt) { \
        const unsigned char* vp_ = (Vc_) + (32 * vt + r) * AT_VROW + (32 * ((g_) >> 1) + 16 * ((g_) & 1) + 4 * hh) * 2; \
        const u32x2 lo_ = *(const u32x2*)vp_, hi_ = *(const u32x2*)(vp_ + 16); (dst_)[vt] = (u32x4){lo_.x, lo_.y, hi_.x, hi_.y}; } } while (0)
#define AT_PV(Vc_, P_) do { u32x4 avA_[4], avB_[4]; \
        AT_VLOAD(avA_, Vc_, 0); AT_VLOAD(avB_, Vc_, 1); __builtin_amdgcn_sched_barrier(0); \
        _Pragma("unroll") for (int vt = 0; vt < 4; ++vt) o[vt] = MFMA32(__builtin_bit_cast(bf16x8, avA_[vt]), (P_)[0][0], o[vt]); \
        __builtin_amdgcn_sched_barrier(0); AT_VLOAD(avA_, Vc_, 2); __builtin_amdgcn_sched_barrier(0); \
        _Pragma("unroll") for (int vt = 0; vt < 4; ++vt) o[vt] = MFMA32(__builtin_bit_cast(bf16x8, avB_[vt]), (P_)[0][1], o[vt]); \
        __builtin_amdgcn_sched_barrier(0); AT_VLOAD(avB_, Vc_, 3); __builtin_amdgcn_sched_barrier(0); \
        _Pragma("unroll") for (int vt = 0; vt < 4; ++vt) o[vt] = MFMA32(__builtin_bit_cast(bf16x8, avA_[vt]), (P_)[1][0], o[vt]); \
        __builtin_amdgcn_sched_barrier(0); \
        _Pragma("unroll") for (int vt = 0; vt < 4; ++vt) o[vt] = MFMA32(__builtin_bit_cast(bf16x8, avB_[vt]), (P_)[1][1], o[vt]); } while (0)
    AT_GLOAD(0); AT_LSTORE(0);
    __syncthreads();
    if (__builtin_amdgcn_readfirstlane(wid) >= 4) __builtin_amdgcn_s_setprio(1);
    int bi = 0;
    for (int t = 0; t < 32; ++t) {
        if (t + 1 < 32) AT_GLOAD(t + 1);
        const int bprev = (bi == 0) ? 2 : bi - 1, bnext = (bi == 2) ? 0 : bi + 1;
        const unsigned char* buf = smem + bi * AT_STAGE;
        const unsigned char* Kc = buf + cmap * 64 * AT_KROW;
        if (late && t > 0) { const unsigned char* Vp = smem + bprev * AT_STAGE + AT_KBYTES; AT_PV(Vp, pprev); }
        f32x16 x[2];
#pragma unroll
        for (int kt = 0; kt < 2; ++kt)
#pragma unroll
            for (int i = 0; i < 16; ++i) x[kt][i] = 0.f;
        {
            bf16x8 kf[4][2];
#pragma unroll
            for (int ks = 0; ks < 4; ++ks)
#pragma unroll
                for (int kt = 0; kt < 2; ++kt) kf[ks][kt] = *(const bf16x8*)(Kc + (32 * kt + r) * AT_KROW + (16 * ks + 8 * hh) * 2);
            __builtin_amdgcn_sched_barrier(0);
#pragma unroll
            for (int ks = 0; ks < 4; ++ks)
#pragma unroll
                for (int kt = 0; kt < 2; ++kt) x[kt] = MFMA32(kf[ks][kt], qf[ks], x[kt]);
        }
        float mx = x[0][0];
#pragma unroll
        for (int i = 0; i < 16; ++i) { mx = fmaxf(mx, x[0][i]); mx = fmaxf(mx, x[1][i]); }
        mx = xhalf_max(mx);
        if (__any(mx > m_run + 8.f)) {
            const float m_new = fmaxf(m_run, mx), alpha = __builtin_amdgcn_exp2f(m_run - m_new);
            m_run = m_new; l_run *= alpha;
#pragma unroll
            for (int vt = 0; vt < 4; ++vt)
#pragma unroll
                for (int i = 0; i < 16; ++i) o[vt][i] *= alpha;
        }
        float ls = 0.f;
#pragma unroll
        for (int kt = 0; kt < 2; ++kt)
#pragma unroll
            for (int i = 0; i < 16; ++i) { const float e = __builtin_amdgcn_exp2f(x[kt][i] - m_run); x[kt][i] = e; ls += e; }
        l_run += ls;
        bf16x8 pcur[2][2];
#pragma unroll
        for (int kt = 0; kt < 2; ++kt)
#pragma unroll
            for (int s = 0; s < 2; ++s) {
                u32x4 pw; pw.x = pk2(x[kt][8 * s], x[kt][8 * s + 1]); pw.y = pk2(x[kt][8 * s + 2], x[kt][8 * s + 3]); pw.z = pk2(x[kt][8 * s + 4], x[kt][8 * s + 5]); pw.w = pk2(x[kt][8 * s + 6], x[kt][8 * s + 7]);
                pcur[kt][s] = __builtin_bit_cast(bf16x8, pw);
            }
        if (!late) { const unsigned char* Vc = buf + AT_KBYTES; AT_PV(Vc, pcur); }
        else {
#pragma unroll
            for (int kt = 0; kt < 2; ++kt)
#pragma unroll
                for (int s = 0; s < 2; ++s) pprev[kt][s] = pcur[kt][s];
        }
        if (t + 1 < 32) AT_LSTORE(bnext);
        __syncthreads();
        bi = bnext;
    }
    if (late) { const unsigned char* Vp = smem + ((bi == 0) ? 2 : bi - 1) * AT_STAGE + AT_KBYTES; AT_PV(Vp, pprev); }
    __builtin_amdgcn_s_setprio(0);
    __syncthreads();
#undef AT_PV
#undef AT_VLOAD
#undef AT_GLOAD
#undef AT_LSTORE
    const float l_tot = xhalf_sum(l_run);
    const float inv = 1.f / l_tot;
    float* ex = (float*)smem + sub * 4096;
    if (cmap == 1) {
        const float sc = inv * lam;
#pragma unroll
        for (int vt = 0; vt < 4; ++vt)
#pragma unroll
            for (int i = 0; i < 16; ++i) ex[(vt * 16 + i) * 64 + lane] = o[vt][i] * sc;
    }
    __syncthreads();
    if (cmap == 0) {
        float ss = 0.f;
#pragma unroll
        for (int vt = 0; vt < 4; ++vt)
#pragma unroll
            for (int i = 0; i < 16; ++i) { const float v = o[vt][i] * inv - ex[(vt * 16 + i) * 64 + lane]; o[vt][i] = v; ss += v * v; }
        ss = xhalf_sum(ss);
        const float rstd = rsqrtf(ss * (1.f / 128.f) + EPS) * 0.8f;
        bf16_t* dst = (bf16_t*)(p.ws + WS_BIG + BG_MIX0) + (size_t)(b * 2048 + qb * 128 + sub * 32 + r) * 2048 + hd * 128;
#pragma unroll
        for (int vt = 0; vt < 4; ++vt)
#pragma unroll
            for (int g4 = 0; g4 < 4; ++g4) {
                const int dv = 32 * vt + 8 * g4 + 4 * hh;
                const f32x4 sg = *(const f32x4*)(p.subln + dv);
                u32x2 w; w.x = pk2(o[vt][4 * g4] * rstd * sg[0], o[vt][4 * g4 + 1] * rstd * sg[1]); w.y = pk2(o[vt][4 * g4 + 2] * rstd * sg[2], o[vt][4 * g4 + 3] * rstd * sg[3]);
                *(u32x2*)(dst + dv) = w;
            }
    }
    __syncthreads();
}

constexpr int GM_ROW = 272;
DI void gmlp_item(const Params& p, unsigned char* smem, int item) {
    const int tid = threadIdx.x, lane = tid & 63, wid = tid >> 6, r = lane & 31, hh = lane >> 5;
    unsigned char* Wl = smem; unsigned char* XT = Wl + 128 * GM_ROW; float* st = (float*)(XT + 128 * GM_ROW);
    const int n = item & 15, g = (item >> 4) & 7, b = item >> 7;
    const int row0 = b * 2048 + n * 128;
    const bf16_t* gvb = (const bf16_t*)(p.ws + WS_BIG + BG_GVB);
    const bf16_t* ub = (const bf16_t*)(p.ws + WS_BIG + BG_U);
    bf16_t* mix = (bf16_t*)(p.ws + WS_BIG + BG_MIX0);
    if (tid < 128) {
        const u64_t* ls = (const u64_t*)(p.ws + WS_LNS) + 2 * (size_t)(row0 + tid);
        const float mean = fx_get(ls) * (1.f / 1024.f), var = fx_get(ls + 1) * (1.f / 1024.f) - mean * mean;
        st[2 * tid] = mean; st[2 * tid + 1] = rsqrtf(fmaxf(var, 0.f) + EPS);
    }
    {
        const f32x4* wsrc = (const f32x4*)(p.w_s + (size_t)g * 128 * 128);
#pragma unroll
        for (int i = 0; i < 8; ++i) { const int e = tid + 512 * i, pr = e >> 5, q4 = e & 31; const f32x4 w = wsrc[e]; u32x2 pk; pk.x = pk2(w[0], w[1]); pk.y = pk2(w[2], w[3]); *(u32x2*)(Wl + pr * GM_ROW + q4 * 8) = pk; }
    }
    __syncthreads();
    {
        const int c = tid & 127, qg = tid >> 7;
        const float lg = p.ln_g[g * 128 + c], lb = p.ln_b[g * 128 + c];
        const bf16_t* xp = gvb + (size_t)(row0 + 32 * qg) * 1024 + g * 128 + c;
#pragma unroll
        for (int q8 = 0; q8 < 4; ++q8) {
            float y[8];
#pragma unroll
            for (int j = 0; j < 8; ++j) { const int q = 32 * qg + 8 * q8 + j; const float xv = bf2f(xp[(size_t)(8 * q8 + j) * 1024]); y[j] = (xv - st[2 * q]) * st[2 * q + 1] * lg + lb; }
            *(u32x4*)(XT + c * GM_ROW + (32 * qg + 8 * q8) * 2) = pack8(y);
        }
    }
    __syncthreads();
    const int pt = wid >> 1, ct0 = (wid & 1) * 2;
    f32x16 acc[2];
#pragma unroll
    for (int i = 0; i < 16; ++i) { acc[0][i] = 0.f; acc[1][i] = 0.f; }
#pragma unroll
    for (int ks = 0; ks < 8; ++ks) {
        const bf16x8 a = *(const bf16x8*)(Wl + (32 * pt + r) * GM_ROW + (16 * ks + 8 * hh) * 2);
#pragma unroll
        for (int cc = 0; cc < 2; ++cc) { const bf16x8 xb = *(const bf16x8*)(XT + (32 * (ct0 + cc) + r) * GM_ROW + (16 * ks + 8 * hh) * 2); acc[cc] = MFMA32(a, xb, acc[cc]); }
    }
#pragma unroll
    for (int cc = 0; cc < 2; ++cc)
#pragma unroll
        for (int i = 0; i < 16; ++i) {
            const int prow = 32 * pt + (i & 3) + 8 * (i >> 2) + 4 * hh, c = 32 * (ct0 + cc) + r; const size_t row = (size_t)(row0 + prow);
            const float sv = acc[cc][i] + p.b_s[g * 128 + prow];
            mix[row * 2048 + 1024 + g * 128 + c] = f2bf(bf2f(ub[row * 1024 + g * 128 + c]) * sv);
        }
    __syncthreads();
}

constexpr int SC_QROW = 272, SC_KROW = 144;
constexpr int SC_QT = 0, SC_KT = 64 * SC_QROW, SC_KD = 2 * 64 * SC_QROW, SC_VT = SC_KD + 128 * SC_KROW, SC_EB = SC_VT + 128 * SC_KROW, SC_BUF = 73728, SC_TOT = 2 * SC_BUF;
struct ScanRaw { unsigned rq[8], rf[8], rv[8]; };
DI void sc_load_f(ScanRaw& R, const unsigned short* proj, int b, int hd, int dir, int c, int tg, int kp) {
#pragma unroll
    for (int i = 0; i < 8; ++i) {
        const int t = 64 * c + 8 * tg + i; const int pos = dir ? (2047 - t) : t;
        R.rf[i] = *(const unsigned*)(proj + (size_t)(b * 2048 + pos) * 10240 + hd * 128 + 2 * kp + 2048 * (1 + dir));
    }
}
DI void sc_load_qv(ScanRaw& R, const unsigned short* proj, int b, int hd, int dir, int c, int tg, int kp) {
#pragma unroll
    for (int i = 0; i < 8; ++i) {
        const int t = 64 * c + 8 * tg + i; const int pos = dir ? (2047 - t) : t;
        const unsigned short* rp = proj + (size_t)(b * 2048 + pos) * 10240 + hd * 128 + 2 * kp;
        R.rq[i] = *(const unsigned*)rp; R.rv[i] = *(const unsigned*)(rp + 6144);
    }
}
DI void sc_totals(const ScanRaw& R, float* TOT, int tg, int kp) {
    float s0 = 0.f, s1 = 0.f;
#pragma unroll
    for (int i = 0; i < 8; ++i) { s0 += h2f((unsigned short)(R.rf[i] & 0xffffu)); s1 += h2f((unsigned short)(R.rf[i] >> 16)); }
    *(f32x2*)(TOT + tg * 128 + 2 * kp) = (f32x2){s0, s1};
}
DI void sc_finalize(const ScanRaw& R, const float* TOT, unsigned char* buf, int tg, int kp) {
    unsigned char* QT = buf + SC_QT; unsigned char* KT = buf + SC_KT; unsigned char* KD = buf + SC_KD; unsigned char* VT = buf + SC_VT; float* EB = (float*)(buf + SC_EB);
    float off0 = 0.f, off1 = 0.f, all0 = 0.f, all1 = 0.f;
#pragma unroll
    for (int g = 0; g < 8; ++g) { const f32x2 tv = *(const f32x2*)(TOT + g * 128 + 2 * kp); all0 += tv[0]; all1 += tv[1]; if (g < tg) { off0 += tv[0]; off1 += tv[1]; } }
    const float ea0 = __expf(all0), ea1 = __expf(all1);
    if (tg == 0) *(f32x2*)(EB + 2 * kp) = (f32x2){ea0, ea1};
    unsigned kd0[4], kd1[4], vv0[4], vv1[4];
    float e0 = __expf(off0), e1 = __expf(off1), pd0 = 0.f, pd1 = 0.f;
#pragma unroll
    for (int i = 0; i < 8; ++i) {
        const float l0 = h2f((unsigned short)(R.rf[i] & 0xffffu)), l1 = h2f((unsigned short)(R.rf[i] >> 16));
        const float f0 = __expf(l0), f1 = __expf(l1);
        e0 *= f0; e1 *= f1;
        const float ie0 = __builtin_amdgcn_rcpf(e0), ie1 = __builtin_amdgcn_rcpf(e1);
        const float q0 = __uint_as_float(R.rq[i] << 16), q1 = __uint_as_float(R.rq[i] & 0xffff0000u);
        *(unsigned*)(QT + (8 * tg + i) * SC_QROW + kp * 4) = pk2(q0 * e0, q1 * e1);
        const float kt0 = (1.f - f0) * ie0, kt1 = (1.f - f1) * ie1;
        *(unsigned*)(KT + (8 * tg + i) * SC_QROW + kp * 4) = pk2(kt0, kt1);
        const float d0 = kt0 * ea0, d1 = kt1 * ea1;
        if (i & 1) { kd0[i >> 1] = pk2(pd0, d0); kd1[i >> 1] = pk2(pd1, d1); vv0[i >> 1] = (R.rv[i - 1] & 0xffffu) | (R.rv[i] << 16); vv1[i >> 1] = (R.rv[i - 1] >> 16) | (R.rv[i] & 0xffff0000u); }
        else { pd0 = d0; pd1 = d1; }
    }
    *(u32x4*)(KD + (2 * kp) * SC_KROW + tg * 16) = (u32x4){kd0[0], kd0[1], kd0[2], kd0[3]};
    *(u32x4*)(KD + (2 * kp + 1) * SC_KROW + tg * 16) = (u32x4){kd1[0], kd1[1], kd1[2], kd1[3]};
    *(u32x4*)(VT + (2 * kp) * SC_KROW + tg * 16) = (u32x4){vv0[0], vv0[1], vv0[2], vv0[3]};
    *(u32x4*)(VT + (2 * kp + 1) * SC_KROW + tg * 16) = (u32x4){vv1[0], vv1[1], vv1[2], vv1[3]};
}
DI void sc_mma(f32x16 (&st)[4], const unsigned char* buf, bf16_t* dst, int vt, int th, int r, int hh) {
    const unsigned char* QT = buf + SC_QT; const unsigned char* KT = buf + SC_KT; const unsigned char* KD = buf + SC_KD; const unsigned char* VT = buf + SC_VT; const float* EB = (const float*)(buf + SC_EB);
    f32x16 o;
#pragma unroll
    for (int i = 0; i < 16; ++i) o[i] = 0.f;
    {
        f32x16 Pd, Pl;
#pragma unroll
        for (int i = 0; i < 16; ++i) { Pd[i] = 0.f; Pl[i] = 0.f; }
#pragma unroll
        for (int ks = 0; ks < 8; ++ks) {
            const bf16x8 bq = *(const bf16x8*)(QT + (32 * th + r) * SC_QROW + (16 * ks + 8 * hh) * 2);
            const bf16x8 ad = *(const bf16x8*)(KT + (32 * th + r) * SC_QROW + (16 * ks + 8 * hh) * 2);
            Pd = MFMA32(ad, bq, Pd);
            if (th == 1) { const bf16x8 al = *(const bf16x8*)(KT + r * SC_QROW + (16 * ks + 8 * hh) * 2); Pl = MFMA32(al, bq, Pl); }
        }
#pragma unroll
        for (int i = 0; i < 16; ++i) { const int srow = (i & 3) + 8 * (i >> 2) + 4 * hh; if (srow > r) Pd[i] = 0.f; }
#pragma unroll
        for (int s2 = 0; s2 < 2; ++s2) {
            {
                u32x4 pw; pw.x = pk2(Pd[8 * s2], Pd[8 * s2 + 1]); pw.y = pk2(Pd[8 * s2 + 2], Pd[8 * s2 + 3]); pw.z = pk2(Pd[8 * s2 + 4], Pd[8 * s2 + 5]); pw.w = pk2(Pd[8 * s2 + 6], Pd[8 * s2 + 7]);
                const unsigned char* vp = VT + (32 * vt + r) * SC_KROW + (32 * th + 16 * s2 + 4 * hh) * 2;
                const u32x2 lo = *(const u32x2*)vp, hi = *(const u32x2*)(vp + 16); const u32x4 av = {lo.x, lo.y, hi.x, hi.y};
                o = MFMA32(__builtin_bit_cast(bf16x8, av), __builtin_bit_cast(bf16x8, pw), o);
            }
            if (th == 1) {
                u32x4 pw; pw.x = pk2(Pl[8 * s2], Pl[8 * s2 + 1]); pw.y = pk2(Pl[8 * s2 + 2], Pl[8 * s2 + 3]); pw.z = pk2(Pl[8 * s2 + 4], Pl[8 * s2 + 5]); pw.w = pk2(Pl[8 * s2 + 6], Pl[8 * s2 + 7]);
                const unsigned char* vp = VT + (32 * vt + r) * SC_KROW + (16 * s2 + 4 * hh) * 2;
                const u32x2 lo = *(const u32x2*)vp, hi = *(const u32x2*)(vp + 16); const u32x4 av = {lo.x, lo.y, hi.x, hi.y};
                o = MFMA32(__builtin_bit_cast(bf16x8, av), __builtin_bit_cast(bf16x8, pw), o);
            }
        }
    }
#pragma unroll
    for (int kt = 0; kt < 4; ++kt)
#pragma unroll
        for (int s2 = 0; s2 < 2; ++s2) {
            u32x4 sw; sw.x = pk2(st[kt][8 * s2], st[kt][8 * s2 + 1]); sw.y = pk2(st[kt][8 * s2 + 2], st[kt][8 * s2 + 3]); sw.z = pk2(st[kt][8 * s2 + 4], st[kt][8 * s2 + 5]); sw.w = pk2(st[kt][8 * s2 + 6], st[kt][8 * s2 + 7]);
            const unsigned char* qp = QT + (32 * th + r) * SC_QROW + (32 * kt + 16 * s2 + 4 * hh) * 2;
            const u32x2 lo = *(const u32x2*)qp, hi = *(const u32x2*)(qp + 16); const u32x4 qv = {lo.x, lo.y, hi.x, hi.y};
            o = MFMA32(__builtin_bit_cast(bf16x8, sw), __builtin_bit_cast(bf16x8, qv), o);
        }
#pragma unroll
    for (int g = 0; g < 4; ++g) { u32x2 w; w.x = pk2(o[4 * g], o[4 * g + 1]); w.y = pk2(o[4 * g + 2], o[4 * g + 3]); *(u32x2*)(dst + 8 * g) = w; }
    bf16x8 vbf[4];
#pragma unroll
    for (int ss = 0; ss < 4; ++ss) vbf[ss] = *(const bf16x8*)(VT + (32 * vt + r) * SC_KROW + (16 * ss + 8 * hh) * 2);
#pragma unroll
    for (int kt = 0; kt < 4; ++kt) {
#pragma unroll
        for (int g = 0; g < 4; ++g) { const f32x4 e = *(const f32x4*)(EB + 32 * kt + 8 * g + 4 * hh);
#pragma unroll
            for (int j = 0; j < 4; ++j) st[kt][4 * g + j] *= e[j]; }
#pragma unroll
        for (int ss = 0; ss < 4; ++ss) {
            const bf16x8 a = *(const bf16x8*)(KD + (32 * kt + r) * SC_KROW + (16 * ss + 8 * hh) * 2);
            st[kt] = MFMA32(a, vbf[ss], st[kt]);
        }
    }
}
#define SC_BARRIER() do { asm volatile("s_waitcnt lgkmcnt(0)" ::: "memory"); __builtin_amdgcn_s_barrier(); asm volatile("" ::: "memory"); } while (0)
DI void scan_mfma(const Params& p, unsigned char* smem) {
    const int tid = threadIdx.x, lane = tid & 63, wid = __builtin_amdgcn_readfirstlane(tid >> 6), r = lane & 31, hh = lane >> 5;
    const int vt = wid & 3, th = wid >> 2;
    const bool prep_first = (__builtin_popcount((unsigned)wid) & 1) != 0;
    unsigned char* buf0 = smem; unsigned char* buf1 = smem + SC_BUF; float* TOT0 = (float*)(smem + SC_TOT); float* TOT1 = TOT0 + 1024;
    const unsigned short* proj = (const unsigned short*)(p.ws + WS_BIG);
    bf16_t* o2 = (bf16_t*)(p.ws + WS_O2);
    const int kp = lane, tg = wid;
    for (int item = blockIdx.x; item < 128; item += gridDim.x) {
        const int hd = item & 15, b = (item >> 4) & 3, dir = item >> 6;
        f32x16 st[4];
#pragma unroll
        for (int kt = 0; kt < 4; ++kt)
#pragma unroll
            for (int i = 0; i < 16; ++i) st[kt][i] = 0.f;
        bf16_t* obase = o2 + (size_t)dir * MROWS * DM + (size_t)(b * 2048) * 2048 + hd * 128 + 32 * vt + 4 * hh;
#define SC_DST(c) (obase + (size_t)(dir ? (2047 - (64 * (c) + 32 * th + r)) : (64 * (c) + 32 * th + r)) * 2048)
        ScanRaw R1, R2;
        sc_load_f(R1, proj, b, hd, dir, 0, tg, kp); sc_load_qv(R1, proj, b, hd, dir, 0, tg, kp); sc_load_f(R2, proj, b, hd, dir, 1, tg, kp);
        sc_totals(R1, TOT0, tg, kp); sc_totals(R2, TOT1, tg, kp);
        SC_BARRIER();
        sc_finalize(R1, TOT0, buf0, tg, kp);
#pragma unroll
        for (int i = 0; i < 8; ++i) R1.rf[i] = R2.rf[i];
        sc_load_qv(R1, proj, b, hd, dir, 1, tg, kp);
        SC_BARRIER();
        if (wid >= 4) __builtin_amdgcn_s_setprio(1);
#pragma clang loop unroll(disable)
        for (int c = 0; c < 32; ++c) {
            unsigned char* bufc = (c & 1) ? buf1 : buf0; unsigned char* bufn = (c & 1) ? buf0 : buf1;
            float* TOTn = (c & 1) ? TOT0 : TOT1; float* TOTnn = (c & 1) ? TOT1 : TOT0;
            if (c + 2 < 32) sc_load_f(R2, proj, b, hd, dir, c + 2, tg, kp);
            if (prep_first && c + 1 < 32) sc_finalize(R1, TOTn, bufn, tg, kp);
            sc_mma(st, bufc, SC_DST(c), vt, th, r, hh);
            if (!prep_first && c + 1 < 32) sc_finalize(R1, TOTn, bufn, tg, kp);
            if (c + 2 < 32) {
                sc_totals(R2, TOTnn, tg, kp);
#pragma unroll
                for (int i = 0; i < 8; ++i) R1.rf[i] = R2.rf[i];
                sc_load_qv(R1, proj, b, hd, dir, c + 2, tg, kp);
            }
            SC_BARRIER();
        }
        __builtin_amdgcn_s_setprio(0);
#undef SC_DST
    }
}

struct ScanRaw16 { unsigned rq[16], rf[16], rv[16]; };
DI void sp_load_f(ScanRaw16& R, const unsigned short* proj, int b, int hd, int dir, int c, int tg, int kp) {
#pragma unroll
    for (int i = 0; i < 16; ++i) {
        const int t = 64 * c + 16 * tg + i; const int pos = dir ? (2047 - t) : t;
        R.rf[i] = *(const unsigned*)(proj + (size_t)(b * 2048 + pos) * 10240 + hd * 128 + 2 * kp + 2048 * (1 + dir));
    }
}
DI void sp_load_qv(ScanRaw16& R, const unsigned short* proj, int b, int hd, int dir, int c, int tg, int kp) {
#pragma unroll
    for (int i = 0; i < 16; ++i) {
        const int t = 64 * c + 16 * tg + i; const int pos = dir ? (2047 - t) : t;
        const unsigned short* rp = proj + (size_t)(b * 2048 + pos) * 10240 + hd * 128 + 2 * kp;
        R.rq[i] = *(const unsigned*)rp; R.rv[i] = *(const unsigned*)(rp + 6144);
    }
}
DI void sp_totals(const unsigned (&rf)[16], float* TOT, int tg, int kp) {
    float s0 = 0.f, s1 = 0.f;
#pragma unroll
    for (int i = 0; i < 16; ++i) { s0 += h2f((unsigned short)(rf[i] & 0xffffu)); s1 += h2f((unsigned short)(rf[i] >> 16)); }
    *(f32x2*)(TOT + tg * 128 + 2 * kp) = (f32x2){s0, s1};
}
DI void sp_finalize(const ScanRaw16& R, const float* TOT, unsigned char* buf, int tg, int kp) {
    unsigned char* QT = buf + SC_QT; unsigned char* KT = buf + SC_KT; unsigned char* KD = buf + SC_KD; unsigned char* VT = buf + SC_VT; float* EB = (float*)(buf + SC_EB);
    float off0 = 0.f, off1 = 0.f, all0 = 0.f, all1 = 0.f;
#pragma unroll
    for (int g = 0; g < 4; ++g) { const f32x2 tv = *(const f32x2*)(TOT + g * 128 + 2 * kp); all0 += tv[0]; all1 += tv[1]; if (g < tg) { off0 += tv[0]; off1 += tv[1]; } }
    const float ea0 = __builtin_amdgcn_exp2f(all0), ea1 = __builtin_amdgcn_exp2f(all1);
    if (tg == 0) *(f32x2*)(EB + 2 * kp) = (f32x2){ea0, ea1};
    unsigned kd0[8], kd1[8], vv0[8], vv1[8];
    float e0 = __builtin_amdgcn_exp2f(off0), e1 = __builtin_amdgcn_exp2f(off1), pd0 = 0.f, pd1 = 0.f;
#pragma unroll
    for (int i = 0; i < 16; ++i) {
        const float l0 = h2f((unsigned short)(R.rf[i] & 0xffffu)), l1 = h2f((unsigned short)(R.rf[i] >> 16));
        const float f0 = __builtin_amdgcn_exp2f(l0), f1 = __builtin_amdgcn_exp2f(l1);
        e0 *= f0; e1 *= f1;
        const float ie0 = __builtin_amdgcn_rcpf(e0), ie1 = __builtin_amdgcn_rcpf(e1);
        const float q0 = __uint_as_float(R.rq[i] << 16), q1 = __uint_as_float(R.rq[i] & 0xffff0000u);
        *(unsigned*)(QT + (16 * tg + i) * SC_QROW + kp * 4) = pk2(q0 * e0, q1 * e1);
        const float kt0 = (1.f - f0) * ie0, kt1 = (1.f - f1) * ie1;
        *(unsigned*)(KT + (16 * tg + i) * SC_QROW + kp * 4) = pk2(kt0, kt1);
        const float d0 = kt0 * ea0, d1 = kt1 * ea1;
        if (i & 1) { kd0[i >> 1] = pk2(pd0, d0); kd1[i >> 1] = pk2(pd1, d1); vv0[i >> 1] = (R.rv[i - 1] & 0xffffu) | (R.rv[i] << 16); vv1[i >> 1] = (R.rv[i - 1] >> 16) | (R.rv[i] & 0xffff0000u); }
        else { pd0 = d0; pd1 = d1; }
    }
#pragma unroll
    for (int q = 0; q < 2; ++q) {
        *(u32x4*)(KD + (2 * kp) * SC_KROW + tg * 32 + q * 16) = (u32x4){kd0[4 * q], kd0[4 * q + 1], kd0[4 * q + 2], kd0[4 * q + 3]};
        *(u32x4*)(KD + (2 * kp + 1) * SC_KROW + tg * 32 + q * 16) = (u32x4){kd1[4 * q], kd1[4 * q + 1], kd1[4 * q + 2], kd1[4 * q + 3]};
        *(u32x4*)(VT + (2 * kp) * SC_KROW + tg * 32 + q * 16) = (u32x4){vv0[4 * q], vv0[4 * q + 1], vv0[4 * q + 2], vv0[4 * q + 3]};
        *(u32x4*)(VT + (2 * kp + 1) * SC_KROW + tg * 32 + q * 16) = (u32x4){vv1[4 * q], vv1[4 * q + 1], vv1[4 * q + 2], vv1[4 * q + 3]};
    }
}
DI void scan_pc(const Params& p, unsigned char* smem) {
    const int tid = threadIdx.x, lane = tid & 63, wid = __builtin_amdgcn_readfirstlane(tid >> 6), r = lane & 31, hh = lane >> 5;
    const bool producer = (__builtin_popcount((unsigned)wid) & 1) != 0;
    const int role = wid >> 1;
    unsigned char* buf0 = smem; unsigned char* buf1 = smem + SC_BUF; float* TOT0 = (float*)(smem + SC_TOT); float* TOT1 = TOT0 + 1024;
    const unsigned short* proj = (const unsigned short*)(p.ws + WS_BIG);
    bf16_t* o2 = (bf16_t*)(p.ws + WS_O2);
    for (int it = blockIdx.x; it < 256; it += gridDim.x) {
        int item = it;
        if (gridDim.x == 256) { const int xcd = it & 7, slot = it >> 3; item = (((slot >> 1) << 3) + xcd) * 2 + (slot & 1); }
        const int vh = item & 1, hd = (item >> 1) & 15, b = (item >> 5) & 3, dir = item >> 7;
        if (producer) {
            const int tg = role, kp = lane;
            ScanRaw16 RA, RB;
            sp_load_f(RB, proj, b, hd, dir, 0, tg, kp); sp_load_qv(RB, proj, b, hd, dir, 0, tg, kp);
            sp_load_f(RA, proj, b, hd, dir, 1, tg, kp); sp_load_qv(RA, proj, b, hd, dir, 1, tg, kp);
            sp_totals(RB.rf, TOT0, tg, kp); sp_totals(RA.rf, TOT1, tg, kp);
            SC_BARRIER();
            sp_finalize(RB, TOT0, buf0, tg, kp);
            sp_load_f(RB, proj, b, hd, dir, 2, tg, kp); sp_load_qv(RB, proj, b, hd, dir, 2, tg, kp);
            SC_BARRIER();
#pragma clang loop unroll(disable)
            for (int c = 0; c < 32; c += 2) {
                sp_finalize(RA, TOT1, buf1, tg, kp);
                if (c + 3 < 32) { sp_load_f(RA, proj, b, hd, dir, c + 3, tg, kp); sp_load_qv(RA, proj, b, hd, dir, c + 3, tg, kp); }
                if (c + 2 < 32) sp_totals(RB.rf, TOT0, tg, kp);
                SC_BARRIER();
                if (c + 2 < 32) sp_finalize(RB, TOT0, buf0, tg, kp);
                if (c + 4 < 32) { sp_load_f(RB, proj, b, hd, dir, c + 4, tg, kp); sp_load_qv(RB, proj, b, hd, dir, c + 4, tg, kp); }
                if (c + 3 < 32) sp_totals(RA.rf, TOT1, tg, kp);
                SC_BARRIER();
            }
        } else {
            const int vt = 2 * vh + (role & 1), th = role >> 1;
            f32x16 st[4];
#pragma unroll
            for (int kt = 0; kt < 4; ++kt)
#pragma unroll
                for (int i = 0; i < 16; ++i) st[kt][i] = 0.f;
            bf16_t* obase = o2 + (size_t)dir * MROWS * DM + (size_t)(b * 2048) * 2048 + hd * 128 + 32 * vt + 4 * hh;
            SC_BARRIER();
            SC_BARRIER();
#pragma clang loop unroll(disable)
            for (int c = 0; c < 32; ++c) {
                const unsigned char* bufc = (c & 1) ? buf1 : buf0;
                const int t = 64 * c + 32 * th + r;
                sc_mma(st, bufc, obase + (size_t)(dir ? (2047 - t) : t) * 2048, vt, th, r, hh);
                SC_BARRIER();
            }
        }
    }
}

DI void postscan_phase(const Params& p) {
    const int lane = threadIdx.x & 63, wid = threadIdx.x >> 6, stride = gridDim.x * 8;
    const bf16_t* o2 = (const bf16_t*)(p.ws + WS_O2);
    const bf16_t* proj = (const bf16_t*)(p.ws + WS_BIG);
    bf16_t* mix = (bf16_t*)(p.ws + WS_H);
    f32x4 gn[4][2];
#pragma unroll
    for (int i = 0; i < 4; ++i) { const float* gp = p.g_norm + (lane + 64 * i) * 8; gn[i][0] = *(const f32x4*)gp; gn[i][1] = *(const f32x4*)(gp + 4); }
    u32x4 fA[4], bA[4], sA[4], fB[4], bB[4], sB[4];
#define PS_LOAD(f, bw, s, row_) do { _Pragma("unroll") for (int i = 0; i < 4; ++i) { const int col = (lane + 64 * i) * 8; \
        (f)[i] = *(const u32x4*)(o2 + (size_t)(row_) * DM + col); (bw)[i] = *(const u32x4*)(o2 + (size_t)MROWS * DM + (size_t)(row_) * DM + col); \
        (s)[i] = *(const u32x4*)(proj + (size_t)(row_) * 10240 + 8192 + col); } } while (0)
#define PS_DO(f, bw, s, row_) do { float v[4][8]; float ss = 0.f; \
        _Pragma("unroll") for (int i = 0; i < 4; ++i) { float a[8], bb[8]; unpack8((f)[i], a); unpack8((bw)[i], bb); \
            _Pragma("unroll") for (int j = 0; j < 8; ++j) { v[i][j] = a[j] + bb[j]; ss += v[i][j] * v[i][j]; } } \
        ss = wave_sum(ss); const float rstd = rsqrtf(ss * (1.f / DM) + EPS); \
        _Pragma("unroll") for (int i = 0; i < 4; ++i) { float sg[8], y[8]; unpack8((s)[i], sg); \
            _Pragma("unroll") for (int j = 0; j < 8; ++j) y[j] = v[i][j] * rstd * gn[i][j >> 2][j & 3] * sg[j]; \
            *(u32x4*)(mix + (size_t)(row_) * DM + (lane + 64 * i) * 8) = pack8(y); } } while (0)
    int row = blockIdx.x * 8 + wid;
    if (row < MROWS) PS_LOAD(fA, bA, sA, row);
    for (; row < MROWS; row += 2 * stride) {
        if (row + stride < MROWS) PS_LOAD(fB, bB, sB, row + stride);
        PS_DO(fA, bA, sA, row);
        if (row + stride < MROWS) {
            if (row + 2 * stride < MROWS) PS_LOAD(fA, bA, sA, row + 2 * stride);
            PS_DO(fB, bB, sB, row + stride);
        }
    }
#undef PS_LOAD
#undef PS_DO
}

#define XB_TMO      128
#define XB_XCNT(j)  (256  + 64 * (j))
#define XB_XSUB(j)  (1280 + 64 * (j))
#define XB_XGEN(j)  (2304 + 64 * (j))
#define XB_TOP      3328
#define XB_TOPGEN   3392
#define XCD_BAR_WORDS 3456
#define XB_SPIN_CAP (1u << 20)
DI unsigned xb_ld(unsigned* p)              { return __hip_atomic_load(p, __ATOMIC_RELAXED, __HIP_MEMORY_SCOPE_AGENT); }
DI unsigned xb_add(unsigned* p, unsigned v) { return __hip_atomic_fetch_add(p, v, __ATOMIC_RELAXED, __HIP_MEMORY_SCOPE_AGENT); }
DI unsigned xb_xcc_id() { return (unsigned)__builtin_amdgcn_s_getreg((3 << 11) | 20) & 0xFu; }
#define XB_SPIN(cond, bar) do { unsigned _sp = 0; while (cond) { __builtin_amdgcn_s_sleep(1); \
    if ((++_sp & 255u) == 0u) { if (xb_ld(&(bar)[XB_TMO])) break; if (_sp > XB_SPIN_CAP) { atomicAdd(&(bar)[XB_TMO], 1u); break; } } } } while (0)
struct XcdBarrier { unsigned* bar; unsigned x; volatile LAS unsigned* st; };
DI XcdBarrier xcd_barrier_post(unsigned* bar, volatile LAS unsigned* st) {
    XcdBarrier b; b.bar = bar; b.x = xb_xcc_id(); b.st = st;
    if (threadIdx.x == 0) (void)xb_add(&bar[XB_XCNT(b.x)], 1u);
    return b;
}
DI void xcd_barrier_complete(unsigned* bar, unsigned x, unsigned& nloc, unsigned& nx) {
    const unsigned G = gridDim.x * gridDim.y * gridDim.z;
    unsigned sum, cnt, mine, sp = 0u;
    for (;;) {
        sum = 0u; cnt = 0u; mine = 0u;
#pragma unroll
        for (unsigned j = 0; j < 16; ++j) { const unsigned c = xb_ld(&bar[XB_XCNT(j)]); sum += c; cnt += (c > 0u) ? 1u : 0u; mine = (j == x) ? c : mine; }
        if (sum == G) break;
        __builtin_amdgcn_s_sleep(1);
        if ((++sp & 255u) == 0u) { if (xb_ld(&bar[XB_TMO])) break; if (sp > XB_SPIN_CAP) { atomicAdd(&bar[XB_TMO], 1u); break; } }
    }
    nloc = mine > 0u ? mine : 1u; nx = cnt > 0u ? cnt : 1u;
}
DI void xcd_barrier(const XcdBarrier& b) {
    asm volatile("s_waitcnt vmcnt(0)" ::: "memory");
    __syncthreads();
    if (threadIdx.x == 0) {
        unsigned* bar = b.bar;
        __builtin_amdgcn_s_waitcnt(0);
        unsigned nloc = b.st[0], nx = b.st[1];
        if (nloc == 0u) { xcd_barrier_complete(bar, b.x, nloc, nx); b.st[0] = nloc; b.st[1] = nx; }
        const unsigned old = xb_add(&bar[XB_XSUB(b.x)], 1u);
        const unsigned gen = old / nloc;
        if (old + 1u == (gen + 1u) * nloc) {
            __builtin_amdgcn_fence(__ATOMIC_RELEASE, "agent");
            asm volatile("s_waitcnt vmcnt(0)" ::: "memory");
            const unsigned og = xb_add(&bar[XB_TOP], 1u);
            const unsigned tg = og / nx;
            if (og + 1u == (tg + 1u) * nx) xb_add(&bar[XB_TOPGEN], 1u);
            else XB_SPIN(xb_ld(&bar[XB_TOPGEN]) == tg, bar);
            __builtin_amdgcn_fence(__ATOMIC_ACQUIRE, "agent");
            xb_add(&bar[XB_XGEN(b.x)], 1u);
            asm volatile("s_waitcnt vmcnt(0)" ::: "memory");
        } else {
            XB_SPIN(xb_ld(&bar[XB_XGEN(b.x)]) == gen, bar);
            __builtin_amdgcn_fence(__ATOMIC_ACQUIRE, "agent");
            asm volatile("s_waitcnt vmcnt(0)" ::: "memory");
        }
    }
    __syncthreads();
}

__global__ void __launch_bounds__(512, 2) mega(Params p, int ph_lo, int ph_hi) {
    extern __shared__ __attribute__((aligned(16))) unsigned char smem[];
    cg::grid_group grid = cg::this_grid();
    unsigned char* ws = p.ws;
    LAS unsigned char* lds = (LAS unsigned char*)smem;
    float* h = (float*)(ws + WS_H);
    bf16_t* hn = (bf16_t*)(ws + WS_HN);
    volatile LAS unsigned* xst = (volatile LAS unsigned*)(lds + LDS_BYTES - 16);
    if (threadIdx.x == 0) { xst[0] = 0u; xst[1] = 0u; }
    __syncthreads();
    const XcdBarrier xbar = xcd_barrier_post((unsigned*)(ws + WS_BAR), xst);
    if (ph_lo > 0) grid.sync();
#define SEAM(k) xcd_barrier(xbar)
#ifndef ONLY_PH
#define ONLY_PH -1
#endif
#ifndef DUP_MASK
#define DUP_MASK 0
#endif
#define PH_BEGIN(k) if ((ONLY_PH < 0 || ONLY_PH == (k)) && ph_lo <= (k) && (k) < ph_hi) { for (int rep_ = 0; rep_ <= ((DUP_MASK >> (k)) & 1); ++rep_) {
#define PH_END(k) if (rep_ < ((DUP_MASK >> (k)) & 1)) xcd_barrier(xbar); } if ((k) + 1 < ph_hi) SEAM(k); }
    PH_BEGIN(0) phase0(p, smem); PH_END(0)
    PH_BEGIN(1) { EpiIn0 E{(bf16_t*)(ws + WS_BIG + BG_QK), (bf16_t*)(ws + WS_BIG + BG_VT), (bf16_t*)(ws + WS_BIG + BG_U), (bf16_t*)(ws + WS_BIG + BG_GVB), (const float*)(ws + WS_TAB), (u64_t*)(ws + WS_LNS)};
                  pg8::gemm_phase(lds, hn, (const bf16_t*)(ws + WS_IN0), MROWS, 5120, 2048, E);
                  int sid, ns; if (gemm_short_block(MROWS, 5120, sid, ns)) {
                      cvt_tiles(sid, ns, (float*)smem, p.even_w_out, nullptr, (bf16_t*)(ws + WS_OUT0), 2048, 2048, 2048, 0, nullptr);
                      cvt_tiles(sid, ns, (float*)smem, p.w_gate, p.w_up, (bf16_t*)(ws + WS_GU0), 2048, FFN, 2 * FFN, 2, p.ffn_norm); } } PH_END(1)
    PH_BEGIN(2) {
            float lam;
            { const int lane = threadIdx.x & 63; const float a = wave_sum(p.lq1[lane] * p.lk1[lane]), bq = wave_sum(p.lq2[lane] * p.lk2[lane]); lam = expf(a) - expf(bq) + 0.2f; }
#ifndef DUP_ATT
#define DUP_ATT 0
#endif
#ifndef DUP_GMLP
#define DUP_GMLP 0
#endif
            for (int rep2 = 0; rep2 <= DUP_ATT; ++rep2) for (int it = blockIdx.x; it < 512; it += gridDim.x) {
                int item = it;
                if (gridDim.x == 256) {
                    const int xcd = blockIdx.x & 7, j = (it >> 8) * 32 + (blockIdx.x >> 3);
                    item = (xcd * 4 + (j >> 4)) * 16 + (j & 15);
                }
                attn_item(p, smem, item, lam);
            }
            for (int rep2 = 0; rep2 <= DUP_GMLP; ++rep2) for (int item = blockIdx.x; item < 512; item += gridDim.x) gmlp_item(p, smem, item);
    } PH_END(2)
    PH_BEGIN(3) { EpiResN<true> E{p.x, hn, (u64_t*)(ws + WS_SSQ)}; pg8::gemm_phase(lds, (const bf16_t*)(ws + WS_BIG + BG_MIX0), (const bf16_t*)(ws + WS_OUT0), MROWS, 2048, 2048, E); } PH_END(3)
    PH_BEGIN(5) { EpiGU E{(bf16_t*)(ws + WS_BIG), (const u64_t*)(ws + WS_SSQ)}; pg8::gemm_phase(lds, hn, (const bf16_t*)(ws + WS_GU0), MROWS, 2 * FFN, 2048, E);
                  int sid, ns; if (gemm_short_block(MROWS, 2 * FFN, sid, ns)) { cvt_tiles(sid, ns, (float*)smem, p.w_down, nullptr, (bf16_t*)(ws + WS_DN0), FFN, 2048, 2048, 0, nullptr);
                      cvt_tiles(sid, ns, (float*)smem, p.hgrn_w_in, nullptr, (bf16_t*)(ws + WS_IN1), 2048, 10240, 10240, 3, p.mix_norm + DM); } } PH_END(5)
    PH_BEGIN(6) { EpiResN<false> E{hn, hn, (u64_t*)(ws + WS_SSQ) + 8192}; pg8::gemm_phase(lds, (const bf16_t*)(ws + WS_BIG), (const bf16_t*)(ws + WS_DN0), MROWS, 2048, FFN, E); } PH_END(6)
    PH_BEGIN(8) { EpiIn1 E{(unsigned short*)(ws + WS_BIG), (const float*)(ws + WS_TAB) + 2048 * 16, (const u64_t*)(ws + WS_SSQ) + 8192}; pg8::gemm_phase(lds, hn, (const bf16_t*)(ws + WS_IN1), MROWS, 10240, 2048, E); } PH_END(8)
    PH_BEGIN(9) {
        scan_pc(p, smem);
        __syncthreads();
        const bool conv = true; const int sid = (int)blockIdx.x, ns = (int)gridDim.x;
        if (conv) {
            cvt_tiles(sid, ns, (float*)smem, p.hgrn_w_out, nullptr, (bf16_t*)(ws + WS_OUT1), 2048, 2048, 2048, 0, nullptr);
            cvt_tiles(sid, ns, (float*)smem, p.w_gate + (size_t)DM * FFN, p.w_up + (size_t)DM * FFN, (bf16_t*)(ws + WS_GU1), 2048, FFN, 2 * FFN, 2, p.ffn_norm + DM);
        }
    } PH_END(9)
    PH_BEGIN(10) postscan_phase(p); PH_END(10)
    PH_BEGIN(11) { EpiResN<false> E{hn, hn, (u64_t*)(ws + WS_SSQ) + 16384}; pg8::gemm_phase(lds, (const bf16_t*)(ws + WS_H), (const bf16_t*)(ws + WS_OUT1), MROWS, 2048, 2048, E); } PH_END(11)
    PH_BEGIN(13) { EpiGU E{(bf16_t*)(ws + WS_BIG), (const u64_t*)(ws + WS_SSQ) + 16384}; pg8::gemm_phase(lds, hn, (const bf16_t*)(ws + WS_GU1), MROWS, 2 * FFN, 2048, E);
                   int sid, ns; if (gemm_short_block(MROWS, 2 * FFN, sid, ns)) cvt_tiles(sid, ns, (float*)smem, p.w_down + (size_t)DM * FFN, nullptr, (bf16_t*)(ws + WS_DN1), FFN, 2048, 2048, 0, nullptr); } PH_END(13)
    if (ph_lo <= 14 && 14 < ph_hi) {
        if (gridDim.x == 256) {
            EpiFinal E{hn, p.out, p.final_norm, (u64_t*)(ws + WS_SSQ3), (unsigned*)(ws + WS_CNT)};
            pg8::gemm_phase(lds, (const bf16_t*)(ws + WS_BIG), (const bf16_t*)(ws + WS_DN1), MROWS, 2048, FFN, E);
        } else {
            { EpiResB E{hn, h}; pg8::gemm_phase(lds, (const bf16_t*)(ws + WS_BIG), (const bf16_t*)(ws + WS_DN1), MROWS, 2048, FFN, E); }
            xcd_barrier(xbar);
            rmsnorm_phase<false>(h, p.final_norm, p.out, (int)(((long)MROWS * blockIdx.x) / gridDim.x), (int)(((long)MROWS * (blockIdx.x + 1)) / gridDim.x));
        }
    }
}

extern "C" void kernel_launch(void* const* d_in, const int* in_sizes, int n_in, void* d_out, int out_size, void* d_ws, size_t ws_size, hipStream_t stream) {
    static int grid_blocks = 0;
    if (!grid_blocks) {
        int dev = 0, cus = 0, per_cu = 0;
        hipGetDevice(&dev);
        hipDeviceGetAttribute(&cus, hipDeviceAttributeMultiprocessorCount, dev);
        hipFuncSetAttribute((const void*)mega, hipFuncAttributeMaxDynamicSharedMemorySize, LDS_BYTES);
        hipOccupancyMaxActiveBlocksPerMultiprocessor(&per_cu, (const void*)mega, 512, LDS_BYTES);
        if (per_cu < 1) { fprintf(stderr, "kernel_launch: occupancy query reports %d blocks per CU\n", per_cu); per_cu = 1; }
        grid_blocks = cus * per_cu;
        if (ws_size < WS_END) fprintf(stderr, "kernel_launch: workspace too small: %zu < %zu\n", ws_size, (size_t)WS_END);
    }
    if (hipMemsetAsync((unsigned char*)d_ws + WS_BAR, 0, 3456 * 4, stream) != hipSuccess) fprintf(stderr, "kernel_launch: memset of barrier words failed\n");
    Params p{};
    const float** pp = (const float**)&p;
    for (int i = 0; i < 22; ++i) pp[i] = (const float*)d_in[i];
    p.out = (float*)d_out; p.ws = (unsigned char*)d_ws;
    int lo = 0, hi = 16;
    void* args[] = {&p, &lo, &hi};
    hipError_t e = hipLaunchCooperativeKernel((const void*)mega, dim3(grid_blocks), dim3(512), args, LDS_BYTES, stream);
    if (e != hipSuccess) fprintf(stderr, "cooperative launch failed: %s (grid %d)\n", hipGetErrorString(e), grid_blocks);
}
```

```cpp
#include <hip/hip_runtime.h>
#include <hip/hip_cooperative_groups.h>
#include <cstdio>
namespace cg = cooperative_groups;

#define DI __device__ __forceinline__
#define LAS __attribute__((address_space(3)))
typedef unsigned short bf16_t;
typedef short bf16x8 __attribute__((ext_vector_type(8)));
typedef float f32x2 __attribute__((ext_vector_type(2)));
typedef float f32x4 __attribute__((ext_vector_type(4)));
typedef float f32x16 __attribute__((ext_vector_type(16)));
typedef unsigned u32x2 __attribute__((ext_vector_type(2)));
typedef unsigned u32x4 __attribute__((ext_vector_type(4)));
typedef __bf16 bf16x2_t __attribute__((ext_vector_type(2)));

constexpr int MROWS = 8192, DM = 2048, SEQ = 2048, FFN = 5632;
constexpr int LDS_BYTES = 156160;
constexpr float EPS = 1e-6f;
constexpr float QSCALE = 0.125f * 1.4426950408889634f;

constexpr size_t SZ_IN0 = (size_t)5120 * 2048 * 2, SZ_OUT = (size_t)2048 * 2048 * 2, SZ_GU = (size_t)11264 * 2048 * 2, SZ_DN = (size_t)2048 * 5632 * 2, SZ_IN1 = (size_t)10240 * 2048 * 2;
constexpr size_t WS_IN0 = 0, WS_OUT0 = WS_IN0 + SZ_IN0, WS_GU0 = WS_OUT0 + SZ_OUT, WS_DN0 = WS_GU0 + SZ_GU;
constexpr size_t WS_IN1 = WS_DN0 + SZ_DN, WS_OUT1 = WS_IN1 + SZ_IN1, WS_GU1 = WS_OUT1 + SZ_OUT, WS_DN1 = WS_GU1 + SZ_GU;
constexpr size_t WS_H = WS_DN1 + SZ_DN;
constexpr size_t WS_HN = WS_H + (size_t)MROWS * DM * 4;
constexpr size_t WS_BIG = WS_HN + (size_t)MROWS * DM * 2;
constexpr size_t SZ_BIG = (size_t)MROWS * 10240 * 2;
constexpr size_t WS_TAB = WS_BIG + SZ_BIG;
constexpr size_t WS_BAR = WS_TAB + 2048 * 16 * 4 + 4096 * 4;
constexpr size_t WS_SSQ = WS_BAR + 3456 * 4 + 256;
constexpr size_t WS_LNS = WS_SSQ + 3 * 8192 * 8;
constexpr size_t WS_SSQ3 = WS_LNS + 2 * 8192 * 8;
constexpr size_t WS_CNT = WS_SSQ3 + 8192 * 8;
constexpr size_t WS_END = WS_CNT + 32 * 64 * 4;
constexpr size_t BG_HB2 = (size_t)96 << 20;
constexpr size_t BG_QK = 0, BG_VT = BG_QK + (size_t)MROWS * 2048 * 2, BG_U = BG_VT + (size_t)MROWS * 1024 * 2, BG_GVB = BG_U + (size_t)MROWS * 1024 * 2, BG_MIX0 = BG_GVB + (size_t)MROWS * 1024 * 2;
constexpr size_t WS_O2 = WS_IN0;

struct Params {
    const float* x; const float* mix_norm; const float* even_w_in; const float* even_w_out;
    const float* lq1; const float* lk1; const float* lq2; const float* lk2; const float* subln;
    const float* ln_g; const float* ln_b; const float* w_s; const float* b_s;
    const float* hgrn_w_in; const float* hgrn_w_out; const float* lower_bounds; const float* g_norm;
    const float* ffn_norm; const float* w_gate; const float* w_up; const float* w_down; const float* final_norm;
    float* out; unsigned char* ws;
};

DI float bf2f(bf16_t b) { return __uint_as_float(((unsigned)b) << 16); }
DI unsigned pk2(float lo, float hi) { f32x2 v = {lo, hi}; bf16x2_t b = __builtin_convertvector(v, bf16x2_t); return __builtin_bit_cast(unsigned, b); }
DI bf16_t f2bf(float f) { return (bf16_t)(pk2(f, 0.f) & 0xffffu); }
DI float h2f(unsigned short b) { return (float)__builtin_bit_cast(_Float16, b); }
DI unsigned short f2h(float f) { return __builtin_bit_cast(unsigned short, (_Float16)f); }
DI float sigmoidf_(float x) { return __builtin_amdgcn_rcpf(1.f + __expf(-x)); }
DI float siluf_(float x) { return x * sigmoidf_(x); }
DI float geluf_(float x) { return x * sigmoidf_(1.5957691216057308f * (x + 0.044715f * x * x * x)); }
DI float wave_sum(float v) {
#pragma unroll
    for (int o = 32; o >= 1; o >>= 1) v += __shfl_xor(v, o);
    return v;
}
DI float xhalf_max(float v) { const auto r = __builtin_amdgcn_permlane32_swap(__float_as_uint(v), __float_as_uint(v), false, false); return fmaxf(__uint_as_float(r[0]), __uint_as_float(r[1])); }
DI float xhalf_sum(float v) { const auto r = __builtin_amdgcn_permlane32_swap(__float_as_uint(v), __float_as_uint(v), false, false); return __uint_as_float(r[0]) + __uint_as_float(r[1]); }
typedef unsigned long long u64_t;
constexpr float FX_SCALE = 1048576.f, FX_INV = 1.f / 1048576.f;
DI void fx_add(u64_t* p, float v) { atomicAdd(p, (u64_t)(long long)__float2ll_rn(v * FX_SCALE)); }
DI float fx_get(const u64_t* p) { return (float)(long long)(*p) * FX_INV; }
DI u32x4 pack8(const float* x) { u32x4 w; w.x = pk2(x[0], x[1]); w.y = pk2(x[2], x[3]); w.z = pk2(x[4], x[5]); w.w = pk2(x[6], x[7]); return w; }
DI void unpack8(u32x4 w, float* x) {
    x[0] = __uint_as_float(w.x << 16); x[1] = __uint_as_float(w.x & 0xffff0000u); x[2] = __uint_as_float(w.y << 16); x[3] = __uint_as_float(w.y & 0xffff0000u);
    x[4] = __uint_as_float(w.z << 16); x[5] = __uint_as_float(w.z & 0xffff0000u); x[6] = __uint_as_float(w.w << 16); x[7] = __uint_as_float(w.w & 0xffff0000u);
}

namespace pg8 {
constexpr int BM = 256, BK = 64, HALF = 128, HTB = HALF * BK * 2, STAGE_BYTES = 8 * HTB, NXCD = 8, WGM = 8;
DI int lds_byte(int r, int c) { const int st = (r >> 4) * 2 + (c >> 5), rr = r & 15, cc = c & 31, ob = rr * 64 + cc * 2; return st * 1024 + (ob ^ (((ob >> 9) & 1) << 5)); }
DI void stage_rc(int b, int& R, int& C) { const int st = b / 1024, sb = b % 1024, swz = sb ^ (((sb >> 9) & 1) << 5); R = (st >> 1) * 16 + swz / 64; C = (st & 1) * 32 + (swz % 64) / 2; }
DI int perm32(int rho) { const int n = rho >> 4, i = rho & 15; return 8 * (i >> 2) + 4 * n + (i & 3); }
struct Unit { int pm, pn; };
struct StaticOrder {
    int nM, nN, nwg, G, c;
    DI void init(int M, int N, int G_, int c_) { nM = M / BM; nN = N / BM; nwg = nM * nN; G = G_; c = c_; }
    DI bool next(int i, Unit& u) const {
        const long L = (long)i * G + c; if (L >= nwg) return false;
        int wgid = (int)L; { const int q = nwg / NXCD, r = nwg % NXCD, xcd = wgid % NXCD, off = wgid / NXCD; wgid = (xcd < r ? xcd * (q + 1) : r * (q + 1) + (xcd - r) * q) + off; }
        const int nig = WGM * nN, gid = wgid / nig, fm = gid * WGM, gsz = (nM - fm) < WGM ? (nM - fm) : WGM;
        u.pm = fm + ((wgid % nig) % gsz); u.pn = (wgid % nig) / gsz; return true;
    }
};

template <class Epi>
DI void gemm_phase(LAS unsigned char* lds, const bf16_t* gA, const bf16_t* gBt, int M, int N, int K, const Epi& E) {
    const int tid = threadIdx.x, wid = __builtin_amdgcn_readfirstlane(tid >> 6), lane = tid & 63, wr = wid >> 2, wc = wid & 3, fr = lane & 15, fq = lane >> 4;
    const int nt = K / BK;
    StaticOrder S; S.init(M, N, (int)gridDim.x, (int)blockIdx.x);
    unsigned voffA[2], voffB[2];
#pragma unroll
    for (int i = 0; i < 2; ++i) { int R, C; stage_rc(tid * 16 + i * 8192, R, C); const int Rb = Epi::PERM ? ((R & ~31) + perm32(R & 31)) : R;
        voffA[i] = (unsigned)(R * K + C) * 2u; voffB[i] = (unsigned)(Rb * K + C) * 2u; }
    const size_t kstep = (size_t)(BK * 2);
    const size_t hstep = (size_t)HALF * K * 2;
    const size_t tstep = 2 * hstep;
    const unsigned ldsw = (unsigned)wid * 1024u;
    const int aoff = lds_byte(wr * 64 + fr, fq * 8), boff = lds_byte(wc * 32 + fr, fq * 8);
#define PG8_SA(b, h) (((b) * 2 + (h)) * HTB)
#define PG8_SB(b, h) ((4 + (b) * 2 + (h)) * HTB)
#define PG8_STAGE(bufoff, gbase, voff) do { _Pragma("unroll") for (int _i = 0; _i < 2; ++_i) \
        __builtin_amdgcn_global_load_lds((const unsigned*)((const char*)(gbase) + (voff)[_i]), (LAS unsigned*)(lds + (bufoff) + ldsw + _i * 8192), 16, 0, 0); } while (0)
#define PG8_LDA(dst, b, h) do { _Pragma("unroll") for (int m = 0; m < 4; ++m) _Pragma("unroll") for (int k = 0; k < 2; ++k) dst[m][k] = *(const LAS bf16x8*)(lds + PG8_SA(b, h) + aoff + m * 2048 + k * 1024); } while (0)
#define PG8_LDB(dst, b, h) do { _Pragma("unroll") for (int n = 0; n < 2; ++n) _Pragma("unroll") for (int k = 0; k < 2; ++k) dst[n][k] = *(const LAS bf16x8*)(lds + PG8_SB(b, h) + boff + n * 2048 + k * 1024); } while (0)
#define PG8_MMA(ai, bj, At, Bt) do { __builtin_amdgcn_s_setprio(1); _Pragma("unroll") for (int m = 0; m < 4; ++m) _Pragma("unroll") for (int n = 0; n < 2; ++n) _Pragma("unroll") for (int k = 0; k < 2; ++k) \
        acc[ai][bj][m][n] = __builtin_amdgcn_mfma_f32_16x16x32_bf16(Bt[n][k], At[m][k], acc[ai][bj][m][n], 0, 0, 0); __builtin_amdgcn_s_setprio(0); } while (0)
#define PG8_WAIT_V(n) asm volatile("s_waitcnt vmcnt(" #n ")" ::: "memory")
#define PG8_WAIT_L(n) asm volatile("s_waitcnt lgkmcnt(" #n ")" ::: "memory")
#define PG8_BAR __builtin_amdgcn_s_barrier()
#define PG8_SCHED __builtin_amdgcn_sched_barrier(0)
    Unit cur, nxt; int ui = 0;
    if (!S.next(0, cur)) return;
    f32x4 acc[2][2][4][2];
#pragma unroll
    for (int a = 0; a < 2; ++a)
#pragma unroll
        for (int b = 0; b < 2; ++b)
#pragma unroll
            for (int m = 0; m < 4; ++m)
#pragma unroll
                for (int n = 0; n < 2; ++n) acc[a][b][m][n] = (f32x4){0.f, 0.f, 0.f, 0.f};
    bf16x8 At[4][2], B0[2][2], B1[2][2];
    const char* cA = (const char*)gA + (size_t)cur.pm * tstep; const char* cB = (const char*)gBt + (size_t)cur.pn * tstep;
    PG8_STAGE(PG8_SB(0, 0), cB, voffB); PG8_STAGE(PG8_SA(0, 0), cA, voffA); PG8_STAGE(PG8_SB(0, 1), cB + hstep, voffB); PG8_STAGE(PG8_SA(0, 1), cA + hstep, voffA);
    if (wr == 1) PG8_BAR;
    PG8_WAIT_V(4); PG8_BAR;
    PG8_STAGE(PG8_SB(1, 0), cB + kstep, voffB); PG8_STAGE(PG8_SA(1, 0), cA + kstep, voffA); PG8_STAGE(PG8_SB(1, 1), cB + hstep + kstep, voffB);
    PG8_WAIT_V(6); PG8_BAR;
    for (;;) {
        const bool has_next = S.next(ui + 1, nxt);
        const char* nA = has_next ? (const char*)gA + (size_t)nxt.pm * tstep : cA; const char* nB = has_next ? (const char*)gBt + (size_t)nxt.pn * tstep : cB;
        for (int t = 0; t < nt; t += 2) {
            const bool last = (t == nt - 2);
            const char* a1 = cA + (size_t)(t + 1) * kstep;
            const char* a2 = last ? nA : cA + (size_t)(t + 2) * kstep; const char* b2 = last ? nB : cB + (size_t)(t + 2) * kstep;
            const char* a3 = a2 + kstep; const char* b3 = b2 + kstep;
            PG8_LDB(B0, 0, 0); PG8_SCHED; PG8_LDA(At, 0, 0); PG8_STAGE(PG8_SA(1, 1), a1 + hstep, voffA);
            PG8_WAIT_L(8); PG8_BAR; PG8_WAIT_L(0); PG8_MMA(0, 0, At, B0); PG8_BAR; PG8_SCHED;
            PG8_LDB(B1, 0, 1); PG8_STAGE(PG8_SB(0, 0), b2, voffB);
            PG8_BAR; PG8_WAIT_L(0); PG8_MMA(0, 1, At, B1); PG8_BAR;
            PG8_LDA(At, 0, 1); PG8_STAGE(PG8_SA(0, 0), a2, voffA);
            PG8_BAR; PG8_WAIT_L(0); PG8_MMA(1, 0, At, B0); PG8_BAR; PG8_SCHED;
            PG8_STAGE(PG8_SB(0, 1), b2 + hstep, voffB);
            PG8_WAIT_V(6); PG8_BAR; PG8_MMA(1, 1, At, B1); PG8_BAR;
            PG8_LDB(B0, 1, 0); PG8_SCHED; PG8_LDA(At, 1, 0); PG8_STAGE(PG8_SA(0, 1), a2 + hstep, voffA);
            PG8_WAIT_L(8); PG8_BAR; PG8_WAIT_L(0); PG8_MMA(0, 0, At, B0); PG8_BAR; PG8_SCHED;
            PG8_LDB(B1, 1, 1); PG8_STAGE(PG8_SB(1, 0), b3, voffB);
            PG8_BAR; PG8_WAIT_L(0); PG8_MMA(0, 1, At, B1); PG8_BAR;
            PG8_LDA(At, 1, 1); PG8_STAGE(PG8_SA(1, 0), a3, voffA);
            PG8_BAR; PG8_WAIT_L(0); PG8_MMA(1, 0, At, B0); PG8_BAR; PG8_SCHED;
            PG8_STAGE(PG8_SB(1, 1), b3 + hstep, voffB);
            PG8_WAIT_V(6); PG8_BAR; PG8_MMA(1, 1, At, B1); PG8_BAR;
        }
        if constexpr (!Epi::AFTER_DRAIN) E(acc, cur, wr, wc, fr, fq);
        if (!has_next) break;
#pragma unroll
        for (int a = 0; a < 2; ++a)
#pragma unroll
            for (int b = 0; b < 2; ++b)
#pragma unroll
                for (int m = 0; m < 4; ++m)
#pragma unroll
                    for (int n = 0; n < 2; ++n) acc[a][b][m][n] = (f32x4){0.f, 0.f, 0.f, 0.f};
        cur = nxt; cA = nA; cB = nB; ++ui;
    }
    PG8_WAIT_V(0);
    if (wr == 0) PG8_BAR;
    PG8_BAR;
    if constexpr (Epi::AFTER_DRAIN) E(acc, cur, wr, wc, fr, fq);
#undef PG8_SA
#undef PG8_SB
#undef PG8_STAGE
#undef PG8_LDA
#undef PG8_LDB
#undef PG8_MMA
#undef PG8_WAIT_V
#undef PG8_WAIT_L
#undef PG8_BAR
#undef PG8_SCHED
}
}

struct EpiIn0 {
    static constexpr bool PERM = true, AFTER_DRAIN = false;
    bf16_t* qk; bf16_t* vT; bf16_t* ub; bf16_t* gvb; const float* rope; u64_t* lns;
    DI void operator()(const f32x4 (&acc)[2][2][4][2], const pg8::Unit& u, int wr, int wc, int fr, int fq) const {
        const int pn = u.pn;
        const int cin = (32 * wc + 8 * fq) & 63;
        const bool ropel = (pn < 8) && (cin < 16);
#pragma unroll
        for (int ai = 0; ai < 2; ++ai) {
            f32x4 rc[1][4][2];
#pragma unroll
            for (int m = 0; m < 4; ++m) {
                const int s = (u.pm * 256 + ai * 128 + wr * 64 + m * 16 + fr) & 2047;
                const float* rp = rope + (s * 8 + (cin >> 1)) * 2;
                if (ropel) { rc[0][m][0] = *(const f32x4*)rp; rc[0][m][1] = *(const f32x4*)(rp + 4); }
                else { rc[0][m][0] = (f32x4){1.f, 0.f, 1.f, 0.f}; rc[0][m][1] = (f32x4){1.f, 0.f, 1.f, 0.f}; }
            }
#pragma unroll
            for (int m = 0; m < 4; ++m) {
                const int row = u.pm * 256 + ai * 128 + wr * 64 + m * 16 + fr, s = row & 2047, b = row >> 11;
                float s1 = 0.f, s2 = 0.f;
#pragma unroll
                for (int bj = 0; bj < 2; ++bj) {
                    const int col0 = pn * 256 + bj * 128 + wc * 32 + fq * 8;
                    float x[8];
#pragma unroll
                    for (int j = 0; j < 4; ++j) { x[j] = acc[ai][bj][m][0][j]; x[4 + j] = acc[ai][bj][m][1][j]; }
                    if (pn < 8) {
                        if (ropel) {
#pragma unroll
                            for (int pp = 0; pp < 4; ++pp) { const float cs = rc[0][m][pp >> 1][2 * (pp & 1)], sn = rc[0][m][pp >> 1][2 * (pp & 1) + 1], x1 = x[2 * pp], x2 = x[2 * pp + 1]; x[2 * pp] = x1 * cs - x2 * sn; x[2 * pp + 1] = x2 * cs + x1 * sn; }
                        }
                        if (pn < 4) {
#pragma unroll
                            for (int j = 0; j < 8; ++j) x[j] *= QSCALE;
                        }
                        *(u32x4*)(qk + (size_t)row * 2048 + col0) = pack8(x);
                    } else if (pn < 12) {
                        const int col = col0 - 2048, hd = col >> 7, d = col & 127;
                        bf16_t* dst = vT + ((size_t)((b * 8 + hd) * 128 + d)) * 2048 + s;
#pragma unroll
                        for (int j = 0; j < 8; ++j) dst[(size_t)j * 2048] = f2bf(x[j]);
                    } else {
#pragma unroll
                        for (int j = 0; j < 8; ++j) { x[j] = geluf_(x[j]); s1 += x[j]; s2 += x[j] * x[j]; }
                        bf16_t* dst = (pn < 16) ? (ub + (size_t)row * 1024 + (col0 - 3072)) : (gvb + (size_t)row * 1024 + (col0 - 4096));
                        *(u32x4*)dst = pack8(x);
                    }
                }
                if (pn >= 16) {
                    s1 += __shfl_xor(s1, 16); s1 += __shfl_xor(s1, 32); s2 += __shfl_xor(s2, 16); s2 += __shfl_xor(s2, 32);
                    if (fq == 0) { fx_add(lns + 2 * row, s1); fx_add(lns + 2 * row + 1, s2); }
                }
            }
        }
    }
};
struct EpiResB {
    static constexpr bool PERM = true, AFTER_DRAIN = false;
    const bf16_t* res; float* out;
    DI void operator()(const f32x4 (&acc)[2][2][4][2], const pg8::Unit& u, int wr, int wc, int fr, int fq) const {
        const int row0 = u.pm * 256 + wr * 64 + fr, col0 = u.pn * 256 + wc * 32 + 8 * fq;
#pragma unroll
        for (int ai = 0; ai < 2; ++ai)
#pragma unroll
            for (int m = 0; m < 4; ++m)
#pragma unroll
                for (int bj = 0; bj < 2; ++bj) {
                    const size_t ro = (size_t)(row0 + ai * 128 + m * 16) * 2048 + col0 + bj * 128;
                    float t[8]; unpack8(*(const u32x4*)(res + ro), t);
                    *(f32x4*)(out + ro) = acc[ai][bj][m][0] + (f32x4){t[0], t[1], t[2], t[3]}; *(f32x4*)(out + ro + 4) = acc[ai][bj][m][1] + (f32x4){t[4], t[5], t[6], t[7]};
                }
    }
};
template <bool RES_F32>
struct EpiResN {
    static constexpr bool PERM = true, AFTER_DRAIN = false;
    const void* res; bf16_t* hb; u64_t* ssq;
    DI void operator()(const f32x4 (&acc)[2][2][4][2], const pg8::Unit& u, int wr, int wc, int fr, int fq) const {
        const int row0 = u.pm * 256 + wr * 64 + fr, col0 = u.pn * 256 + wc * 32 + 8 * fq;
#pragma unroll
        for (int ai = 0; ai < 2; ++ai) {
            f32x4 r[4][2][2];
#pragma unroll
            for (int m = 0; m < 4; ++m)
#pragma unroll
                for (int bj = 0; bj < 2; ++bj) {
                    const size_t ro = (size_t)(row0 + ai * 128 + m * 16) * 2048 + col0 + bj * 128;
                    if (RES_F32) { const float* rp = (const float*)res + ro; r[m][bj][0] = *(const f32x4*)rp; r[m][bj][1] = *(const f32x4*)(rp + 4); }
                    else { float t[8]; unpack8(*(const u32x4*)((const bf16_t*)res + ro), t); r[m][bj][0] = (f32x4){t[0], t[1], t[2], t[3]}; r[m][bj][1] = (f32x4){t[4], t[5], t[6], t[7]}; }
                }
#pragma unroll
            for (int m = 0; m < 4; ++m) {
                const int row = row0 + ai * 128 + m * 16; const size_t ro = (size_t)row * 2048 + col0;
                float ss = 0.f;
#pragma unroll
                for (int bj = 0; bj < 2; ++bj) {
                    const f32x4 v0 = acc[ai][bj][m][0] + r[m][bj][0], v1 = acc[ai][bj][m][1] + r[m][bj][1];
                    u32x4 w; w.x = pk2(v0[0], v0[1]); w.y = pk2(v0[2], v0[3]); w.z = pk2(v1[0], v1[1]); w.w = pk2(v1[2], v1[3]);
                    *(u32x4*)(hb + ro + bj * 128) = w;
                    ss += v0[0] * v0[0] + v0[1] * v0[1] + v0[2] * v0[2] + v0[3] * v0[3] + v1[0] * v1[0] + v1[1] * v1[1] + v1[2] * v1[2] + v1[3] * v1[3];
                }
                ss += __shfl_xor(ss, 16); ss += __shfl_xor(ss, 32);
                if (fq == 0) fx_add(ssq + row, ss);
            }
        }
    }
};
struct EpiFinal {
    static constexpr bool PERM = true, AFTER_DRAIN = true;
    const bf16_t* res; float* out; const float* g; u64_t* ssq; unsigned* cnt;
    DI void operator()(const f32x4 (&acc)[2][2][4][2], const pg8::Unit& u, int wr, int wc, int fr, int fq) const {
        const int row0 = u.pm * 256 + wr * 64 + fr, col0 = u.pn * 256 + wc * 32 + 8 * fq;
        f32x4 v[2][4][2][2];
#pragma unroll
        for (int ai = 0; ai < 2; ++ai) {
            f32x4 r[4][2][2];
#pragma unroll
            for (int m = 0; m < 4; ++m)
#pragma unroll
                for (int bj = 0; bj < 2; ++bj) { float t[8]; unpack8(*(const u32x4*)(res + (size_t)(row0 + ai * 128 + m * 16) * 2048 + col0 + bj * 128), t); r[m][bj][0] = (f32x4){t[0], t[1], t[2], t[3]}; r[m][bj][1] = (f32x4){t[4], t[5], t[6], t[7]}; }
#pragma unroll
            for (int m = 0; m < 4; ++m) {
                float ss = 0.f;
#pragma unroll
                for (int bj = 0; bj < 2; ++bj)
#pragma unroll
                    for (int n = 0; n < 2; ++n) { const f32x4 t = acc[ai][bj][m][n] + r[m][bj][n]; v[ai][m][bj][n] = t; ss += t[0] * t[0] + t[1] * t[1] + t[2] * t[2] + t[3] * t[3]; }
                ss += __shfl_xor(ss, 16); ss += __shfl_xor(ss, 32);
                if (fq == 0) fx_add(ssq + row0 + ai * 128 + m * 16, ss);
            }
        }
        asm volatile("s_waitcnt vmcnt(0)" ::: "memory");
        __syncthreads();
        unsigned* c = cnt + 64 * u.pm;
        if (threadIdx.x == 0) {
            __hip_atomic_fetch_add(c, 1u, __ATOMIC_RELAXED, __HIP_MEMORY_SCOPE_AGENT);
            unsigned spins = 0;
            while (__hip_atomic_load(c, __ATOMIC_RELAXED, __HIP_MEMORY_SCOPE_AGENT) < 8u) { __builtin_amdgcn_s_sleep(4); if (++spins > (1u << 21)) break; }
        }
        __syncthreads();
        __builtin_amdgcn_fence(__ATOMIC_ACQUIRE, "agent");
        f32x4 gv[2][2];
#pragma unroll
        for (int bj = 0; bj < 2; ++bj) { gv[bj][0] = *(const f32x4*)(g + col0 + bj * 128); gv[bj][1] = *(const f32x4*)(g + col0 + bj * 128 + 4); }
#pragma unroll
        for (int ai = 0; ai < 2; ++ai)
#pragma unroll
            for (int m = 0; m < 4; ++m) {
                const int row = row0 + ai * 128 + m * 16;
                const float rs = rsqrtf((float)(long long)__hip_atomic_load(ssq + row, __ATOMIC_RELAXED, __HIP_MEMORY_SCOPE_AGENT) * FX_INV * (1.f / DM) + EPS);
#pragma unroll
                for (int bj = 0; bj < 2; ++bj)
#pragma unroll
                    for (int n = 0; n < 2; ++n) *(f32x4*)(out + (size_t)row * 2048 + col0 + bj * 128 + 4 * n) = v[ai][m][bj][n] * rs * gv[bj][n];
            }
    }
};
struct EpiGU {
    static constexpr bool PERM = true, AFTER_DRAIN = false;
    bf16_t* act; const u64_t* ssq;
    DI void operator()(const f32x4 (&acc)[2][2][4][2], const pg8::Unit& u, int wr, int wc, int fr, int fq) const {
        const int row0 = u.pm * 256 + wr * 64 + fr, col0 = u.pn * 128 + wc * 32 + 8 * fq;
        float rs[2][4];
#pragma unroll
        for (int ai = 0; ai < 2; ++ai)
#pragma unroll
            for (int m = 0; m < 4; ++m) rs[ai][m] = fx_get(ssq + row0 + ai * 128 + m * 16);
#pragma unroll
        for (int ai = 0; ai < 2; ++ai)
#pragma unroll
            for (int m = 0; m < 4; ++m) {
                float x[8];
                const float r = rsqrtf(rs[ai][m] * (1.f / DM) + EPS);
#pragma unroll
                for (int j = 0; j < 4; ++j) { x[j] = siluf_(acc[ai][0][m][0][j] * r) * (acc[ai][1][m][0][j] * r); x[4 + j] = siluf_(acc[ai][0][m][1][j] * r) * (acc[ai][1][m][1][j] * r); }
                *(u32x4*)(act + (size_t)(row0 + ai * 128 + m * 16) * FFN + col0) = pack8(x);
            }
    }
};
struct EpiIn1 {
    static constexpr bool PERM = true, AFTER_DRAIN = false;
    unsigned short* proj; const float* lbtab; const u64_t* ssq;
    DI void operator()(const f32x4 (&acc)[2][2][4][2], const pg8::Unit& u, int wr, int wc, int fr, int fq) const {
        const int pn = u.pn;
        const bool gate = (pn >= 8 && pn < 24);
        float rs[2][4]; f32x4 lbv[2][2];
#pragma unroll
        for (int ai = 0; ai < 2; ++ai)
#pragma unroll
            for (int m = 0; m < 4; ++m) rs[ai][m] = fx_get(ssq + u.pm * 256 + ai * 128 + wr * 64 + m * 16 + fr);
#pragma unroll
        for (int bj = 0; bj < 2; ++bj) {
            const float* lb = lbtab + (gate ? (pn * 256 + bj * 128 + wc * 32 + fq * 8 - 2048) : 0);
            lbv[bj][0] = *(const f32x4*)lb; lbv[bj][1] = *(const f32x4*)(lb + 4);
        }
#pragma unroll
        for (int ai = 0; ai < 2; ++ai)
#pragma unroll
            for (int m = 0; m < 4; ++m) {
                const int row = u.pm * 256 + ai * 128 + wr * 64 + m * 16 + fr;
                const float r = rsqrtf(rs[ai][m] * (1.f / DM) + EPS);
#pragma unroll
                for (int bj = 0; bj < 2; ++bj) {
                    const int col0 = pn * 256 + bj * 128 + wc * 32 + fq * 8;
                    float x[8];
#pragma unroll
                    for (int j = 0; j < 4; ++j) { x[j] = acc[ai][bj][m][0][j] * r; x[4 + j] = acc[ai][bj][m][1][j] * r; }
                    u32x4 w;
                    if (gate) {
                        unsigned short hv[8];
#pragma unroll
                        for (int j = 0; j < 8; ++j) { const float l = lbv[bj][j >> 2][j & 3]; hv[j] = f2h(__log2f(l + (1.f - l) * sigmoidf_(x[j]))); }
                        w.x = hv[0] | ((unsigned)hv[1] << 16); w.y = hv[2] | ((unsigned)hv[3] << 16); w.z = hv[4] | ((unsigned)hv[5] << 16); w.w = hv[6] | ((unsigned)hv[7] << 16);
                    } else {
                        if (pn < 8 || pn >= 32) {
#pragma unroll
                            for (int j = 0; j < 8; ++j) x[j] = siluf_(x[j]);
                        }
                        w = pack8(x);
                    }
                    *(u32x4*)(proj + (size_t)row * 10240 + col0) = w;
                }
            }
    }
};

DI void cvt_tiles(int bid, int nb, float* tl, const float* s0, const float* s1, bf16_t* dst, int K, int Nsrc, int Ndst, int mode, const float* gk) {
    const int tid = threadIdx.x, tk = K / 64, tn = Ndst / 256, ntile = tk * tn;
    f32x4 v[8];
#define CVT_LOAD(tile_) do { const int r0_ = ((tile_) / tk) * 256, k0_ = ((tile_) % tk) * 64; \
        _Pragma("unroll") for (int i = 0; i < 8; ++i) { const int idx_ = tid + 512 * i, kk_ = k0_ + (idx_ >> 6), c4_ = idx_ & 63; const float* sp_; \
            if (mode == 2) sp_ = ((c4_ < 32) ? s0 : s1) + (size_t)kk_ * Nsrc + (r0_ >> 1) + 4 * (c4_ & 31); else sp_ = s0 + (size_t)kk_ * Nsrc + r0_ + 4 * c4_; \
            f32x4 x_ = __builtin_nontemporal_load((const f32x4*)sp_); if (gk) x_ *= gk[kk_]; v[i] = x_; } } while (0)
    int tile = bid;
    if (tile < ntile) CVT_LOAD(tile);
    for (; tile < ntile; tile += nb) {
#pragma unroll
        for (int i = 0; i < 8; ++i) { const int idx = tid + 512 * i; float* d = tl + (idx >> 6) * 257 + 4 * (idx & 63); d[0] = v[i][0]; d[1] = v[i][1]; d[2] = v[i][2]; d[3] = v[i][3]; }
        __syncthreads();
        if (tile + nb < ntile) CVT_LOAD(tile + nb);
        {
            const int r0 = (tile / tk) * 256, k0 = (tile % tk) * 64, kc = tid & 7;
#pragma unroll
            for (int i = 0; i < 4; ++i) {
                const int rr = (tid >> 3) + 64 * i; int col = rr;
                if (mode == 1) { const int j = rr & 63; if (r0 < 2048 && j < 16) col = (rr & ~63) + ((j & 1) ? 8 + (j >> 1) : (j >> 1)); }
                float x[8];
#pragma unroll
                for (int j = 0; j < 8; ++j) x[j] = tl[(kc * 8 + j) * 257 + col];
                __builtin_nontemporal_store(pack8(x), (u32x4*)(dst + (size_t)(r0 + rr) * K + k0 + kc * 8));
            }
        }
        __syncthreads();
    }
#undef CVT_LOAD
}
DI bool gemm_short_block(int M, int N, int& sid, int& ns) {
    const int nwg = (M / 256) * (N / 256), rem = nwg % (int)gridDim.x;
    if (rem == 0) { sid = (int)blockIdx.x; ns = (int)gridDim.x; return true; }
    if ((int)blockIdx.x < rem) return false;
    sid = (int)blockIdx.x - rem; ns = (int)gridDim.x - rem; return true;
}

template <bool OUT_BF16>
DI void rmsnorm_phase(const float* src, const float* g, void* dst, int rb, int re) {
    const int lane = threadIdx.x & 63, wid = threadIdx.x >> 6, stride = 8;
    f32x4 vA[8], vB[8];
#define RN_LOAD(v, row_) do { const f32x4* sp_ = (const f32x4*)(src + (size_t)(row_) * DM); _Pragma("unroll") for (int i = 0; i < 8; ++i) (v)[i] = sp_[lane + 64 * i]; } while (0)
#define RN_DO(v, row_) do { float ss = 0.f; _Pragma("unroll") for (int i = 0; i < 8; ++i) ss += (v)[i][0] * (v)[i][0] + (v)[i][1] * (v)[i][1] + (v)[i][2] * (v)[i][2] + (v)[i][3] * (v)[i][3]; \
        ss = wave_sum(ss); const float rstd = rsqrtf(ss * (1.f / DM) + EPS); \
        _Pragma("unroll") for (int i = 0; i < 8; ++i) { const f32x4 gv = ((const f32x4*)g)[lane + 64 * i]; const f32x4 y = (v)[i] * rstd * gv; \
            if (OUT_BF16) { u32x2 w; w.x = pk2(y[0], y[1]); w.y = pk2(y[2], y[3]); *(u32x2*)((bf16_t*)dst + (size_t)(row_) * DM + (lane + 64 * i) * 4) = w; } \
            else *(f32x4*)((float*)dst + (size_t)(row_) * DM + (lane + 64 * i) * 4) = y; } } while (0)
    int row = rb + wid;
    if (row < re) RN_LOAD(vA, row);
    for (; row < re; row += 2 * stride) {
        if (row + stride < re) RN_LOAD(vB, row + stride);
        RN_DO(vA, row);
        if (row + stride < re) {
            if (row + 2 * stride < re) RN_LOAD(vA, row + 2 * stride);
            RN_DO(vB, row + stride);
        }
    }
#undef RN_LOAD
#undef RN_DO
}

DI void phase0(const Params& p, unsigned char* smem) {
    unsigned char* ws = p.ws; float* tl = (float*)smem;
    float* rope = (float*)(ws + WS_TAB); float* lbt = rope + 2048 * 16;
    const int rbid = (int)gridDim.x - 1 - (int)blockIdx.x;
    for (int e = rbid * 512 + threadIdx.x; e < 2048 * 8; e += gridDim.x * 512) {
        const int s = e >> 3, i = e & 7; const float inv = powf(500000.f, -(float)i / 8.f); const float ang = (float)s * inv;
        rope[2 * e] = cosf(ang); rope[2 * e + 1] = sinf(ang);
    }
    for (int e = rbid * 512 + threadIdx.x; e < 4096; e += gridDim.x * 512) {
        const int d = e >> 11, w = e & 2047; const float l0 = p.lower_bounds[d * 4096 + w], l1 = p.lower_bounds[d * 4096 + 2048 + w];
        lbt[e] = 1.f / (1.f + expf(l0 - l1));
    }
    for (int e = blockIdx.x * 512 + threadIdx.x; e < 12 * 8192 + 32 * 64; e += gridDim.x * 512) ((unsigned*)(ws + WS_SSQ))[e] = 0u;
    {
        int rb, re; const int G = (int)gridDim.x, b = (int)blockIdx.x;
        if (G == 256) { if (b < 128) { rb = 28 * b; re = rb + 28; } else { rb = 3584 + 36 * (b - 128); re = rb + 36; } }
        else { rb = (int)(((long)MROWS * b) / G); re = (int)(((long)MROWS * (b + 1)) / G); }
        rmsnorm_phase<true>(p.x, p.mix_norm, ws + WS_HN, rb, re);
    }
    cvt_tiles(blockIdx.x, gridDim.x, tl, p.even_w_in, nullptr, (bf16_t*)(ws + WS_IN0), 2048, 5120, 5120, 1, nullptr);
}

#define MFMA32(a, b, c) __builtin_amdgcn_mfma_f32_32x32x16_bf16((a), (b), (c), 0, 0, 0)
constexpr int AT_KROW = 144, AT_VROW = 136, AT_KBYTES = 2 * 64 * AT_KROW, AT_STAGE = AT_KBYTES + 128 * AT_VROW;
DI void attn_item(const Params& p, unsigned char* smem, int item, float lam) {
    const int tid = threadIdx.x, lane = tid & 63, wid = tid >> 6, r = lane & 31, hh = lane >> 5;
    const int cmap = wid & 1, sub = wid >> 1;
    const int qb = item & 15, hd = (item >> 4) & 7, b = item >> 7;
    const bf16_t* qkb = (const bf16_t*)(p.ws + WS_BIG + BG_QK) + (size_t)b * 2048 * 2048;
    const bf16_t* kbase = qkb + 1024 + hd * 128;
    const bf16_t* vbase = (const bf16_t*)(p.ws + WS_BIG + BG_VT) + (size_t)((b * 8 + hd) * 128) * 2048;
    bf16x8 qf[4];
    {
        const bf16_t* qp = qkb + (size_t)(qb * 128 + sub * 32 + r) * 2048 + hd * 128 + cmap * 64 + 8 * hh;
#pragma unroll
        for (int ks = 0; ks < 4; ++ks) qf[ks] = *(const bf16x8*)(qp + 16 * ks);
    }
    f32x16 o[4];
#pragma unroll
    for (int vt = 0; vt < 4; ++vt)
#pragma unroll
        for (int i = 0; i < 16; ++i) o[vt][i] = 0.f;
    float m_run = -1e30f, l_run = 0.f;
    const int ke0 = tid, ke1 = tid + 512;
    const int kkey0 = ke0 >> 4, kpart0 = ke0 & 15, kkey1 = ke1 >> 4, kpart1 = ke1 & 15;
    const int klds0 = ((kpart0 >> 3) * 64 + kkey0) * AT_KROW + (kpart0 & 7) * 16, klds1 = ((kpart1 >> 3) * 64 + kkey1) * AT_KROW + (kpart1 & 7) * 16;
    const int vdv0 = ke0 >> 3, vpart0 = ke0 & 7, vdv1 = ke1 >> 3, vpart1 = ke1 & 7;
    const int vlds0 = AT_KBYTES + vdv0 * AT_VROW + vpart0 * 16, vlds1 = AT_KBYTES + vdv1 * AT_VROW + vpart1 * 16;
    u32x4 kr0, kr1, vr0, vr1;
#define AT_GLOAD(t) do { \
        kr0 = *(const u32x4*)(kbase + (size_t)((t) * 64 + kkey0) * 2048 + kpart0 * 8); kr1 = *(const u32x4*)(kbase + (size_t)((t) * 64 + kkey1) * 2048 + kpart1 * 8); \
        vr0 = *(const u32x4*)(vbase + (size_t)vdv0 * 2048 + (t) * 64 + vpart0 * 8); vr1 = *(const u32x4*)(vbase + (size_t)vdv1 * 2048 + (t) * 64 + vpart1 * 8); } while (0)
#define AT_LSTORE(buf) do { unsigned char* _b = smem + (buf) * AT_STAGE; \
        *(u32x4*)(_b + klds0) = kr0; *(u32x4*)(_b + klds1) = kr1; \
        *(u32x2*)(_b + vlds0) = (u32x2){vr0.x, vr0.y}; *(u32x2*)(_b + vlds0 + 8) = (u32x2){vr0.z, vr0.w}; \
        *(u32x2*)(_b + vlds1) = (u32x2){vr1.x, vr1.y}; *(u32x2*)(_b + vlds1 + 8) = (u32x2){vr1.z, vr1.w}; } while (0)
    const bool late = (__builtin_popcount((unsigned)wid) & 1) != 0;
    bf16x8 pprev[2][2];
#pragma unroll
    for (int kt = 0; kt < 2; ++kt)
#pragma unroll
        for (int s = 0; s < 2; ++s)
#pragma unroll
            for (int j = 0; j < 8; ++j) pprev[kt][s][j] = 0;
#define AT_VLOAD(dst_, Vc_, g_) do { _Pragma("unroll") for (int vt = 0; vt < 4; ++vt) { \
        const unsigned char* vp_ = (Vc_) + (32 * vt + r) * AT_VROW + (32 * ((g_) >> 1) + 16 * ((g_) & 1) + 4 * hh) * 2; \
        const u32x2 lo_ = *(const u32x2*)vp_, hi_ = *(const u32x2*)(vp_ + 16); (dst_)[vt] = (u32x4){lo_.x, lo_.y, hi_.x, hi_.y}; } } while (0)
#define AT_PV(Vc_, P_) do { u32x4 avA_[4], avB_[4]; \
        AT_VLOAD(avA_, Vc_, 0); AT_VLOAD(avB_, Vc_, 1); __builtin_amdgcn_sched_barrier(0); \
        _Pragma("unroll") for (int vt = 0; vt < 4; ++vt) o[vt] = MFMA32(__builtin_bit_cast(bf16x8, avA_[vt]), (P_)[0][0], o[vt]); \
        __builtin_amdgcn_sched_barrier(0); AT_VLOAD(avA_, Vc_, 2); __builtin_amdgcn_sched_barrier(0); \
        _Pragma("unroll") for (int vt = 0; vt < 4; ++vt) o[vt] = MFMA32(__builtin_bit_cast(bf16x8, avB_[vt]), (P_)[0][1], o[vt]); \
        __builtin_amdgcn_sched_barrier(0); AT_VLOAD(avB_, Vc_, 3); __builtin_amdgcn_sched_barrier(0); \
        _Pragma("unroll") for (int vt = 0; vt < 4; ++vt) o[vt] = MFMA32(__builtin_bit_cast(bf16x8, avA_[vt]), (P_)[1][0], o[vt]); \
        __builtin_amdgcn_sched_barrier(0); \
        _Pragma("unroll") for (int vt = 0; vt < 4; ++vt) o[vt] = MFMA32(__builtin_bit_cast(bf16x8, avB_[vt]), (P_)[1][1], o[vt]); } while (0)
    AT_GLOAD(0); AT_LSTORE(0);
    __syncthreads();
    int bi = 0;
    for (int t = 0; t < 32; ++t) {
        if (t + 1 < 32) AT_GLOAD(t + 1);
        const int bprev = (bi == 0) ? 2 : bi - 1, bnext = (bi == 2) ? 0 : bi + 1;
        const unsigned char* buf = smem + bi * AT_STAGE;
        const unsigned char* Kc = buf + cmap * 64 * AT_KROW;
        if (late && t > 0) { const unsigned char* Vp = smem + bprev * AT_STAGE + AT_KBYTES; AT_PV(Vp, pprev); }
        f32x16 x[2];
#pragma unroll
        for (int kt = 0; kt < 2; ++kt)
#pragma unroll
            for (int i = 0; i < 16; ++i) x[kt][i] = 0.f;
        {
            bf16x8 kf[4][2];
#pragma unroll
            for (int ks = 0; ks < 4; ++ks)
#pragma unroll
                for (int kt = 0; kt < 2; ++kt) kf[ks][kt] = *(const bf16x8*)(Kc + (32 * kt + r) * AT_KROW + (16 * ks + 8 * hh) * 2);
            __builtin_amdgcn_sched_barrier(0);
#pragma unroll
            for (int ks = 0; ks < 4; ++ks)
#pragma unroll
                for (int kt = 0; kt < 2; ++kt) x[kt] = MFMA32(kf[ks][kt], qf[ks], x[kt]);
        }
        float mx = x[0][0];
#pragma unroll
        for (int i = 0; i < 16; ++i) { mx = fmaxf(mx, x[0][i]); mx = fmaxf(mx, x[1][i]); }
        mx = xhalf_max(mx);
        if (__any(mx > m_run + 8.f)) {
            const float m_new = fmaxf(m_run, mx), alpha = __builtin_amdgcn_exp2f(m_run - m_new);
            m_run = m_new; l_run *= alpha;
#pragma unroll
            for (int vt = 0; vt < 4; ++vt)
#pragma unroll
                for (int i = 0; i < 16; ++i) o[vt][i] *= alpha;
        }
        float ls = 0.f;
#pragma unroll
        for (int kt = 0; kt < 2; ++kt)
#pragma unroll
            for (int i = 0; i < 16; ++i) { const float e = __builtin_amdgcn_exp2f(x[kt][i] - m_run); x[kt][i] = e; ls += e; }
        l_run += ls;
        bf16x8 pcur[2][2];
#pragma unroll
        for (int kt = 0; kt < 2; ++kt)
#pragma unroll
            for (int s = 0; s < 2; ++s) {
                u32x4 pw; pw.x = pk2(x[kt][8 * s], x[kt][8 * s + 1]); pw.y = pk2(x[kt][8 * s + 2], x[kt][8 * s + 3]); pw.z = pk2(x[kt][8 * s + 4], x[kt][8 * s + 5]); pw.w = pk2(x[kt][8 * s + 6], x[kt][8 * s + 7]);
                pcur[kt][s] = __builtin_bit_cast(bf16x8, pw);
            }
        if (!late) { const unsigned char* Vc = buf + AT_KBYTES; AT_PV(Vc, pcur); }
        else {
#pragma unroll
            for (int kt = 0; kt < 2; ++kt)
#pragma unroll
                for (int s = 0; s < 2; ++s) pprev[kt][s] = pcur[kt][s];
        }
        if (t + 1 < 32) AT_LSTORE(bnext);
        __syncthreads();
        bi = bnext;
    }
    if (late) { const unsigned char* Vp = smem + ((bi == 0) ? 2 : bi - 1) * AT_STAGE + AT_KBYTES; AT_PV(Vp, pprev); }
    __syncthreads();
#undef AT_PV
#undef AT_VLOAD
#undef AT_GLOAD
#undef AT_LSTORE
    const float l_tot = xhalf_sum(l_run);
    const float inv = 1.f / l_tot;
    float* ex = (float*)smem + sub * 4096;
    if (cmap == 1) {
        const float sc = inv * lam;
#pragma unroll
        for (int vt = 0; vt < 4; ++vt)
#pragma unroll
            for (int i = 0; i < 16; ++i) ex[(vt * 16 + i) * 64 + lane] = o[vt][i] * sc;
    }
    __syncthreads();
    if (cmap == 0) {
        float ss = 0.f;
#pragma unroll
        for (int vt = 0; vt < 4; ++vt)
#pragma unroll
            for (int i = 0; i < 16; ++i) { const float v = o[vt][i] * inv - ex[(vt * 16 + i) * 64 + lane]; o[vt][i] = v; ss += v * v; }
        ss = xhalf_sum(ss);
        const float rstd = rsqrtf(ss * (1.f / 128.f) + EPS) * 0.8f;
        bf16_t* dst = (bf16_t*)(p.ws + WS_BIG + BG_MIX0) + (size_t)(b * 2048 + qb * 128 + sub * 32 + r) * 2048 + hd * 128;
#pragma unroll
        for (int vt = 0; vt < 4; ++vt)
#pragma unroll
            for (int g4 = 0; g4 < 4; ++g4) {
                const int dv = 32 * vt + 8 * g4 + 4 * hh;
                const f32x4 sg = *(const f32x4*)(p.subln + dv);
                u32x2 w; w.x = pk2(o[vt][4 * g4] * rstd * sg[0], o[vt][4 * g4 + 1] * rstd * sg[1]); w.y = pk2(o[vt][4 * g4 + 2] * rstd * sg[2], o[vt][4 * g4 + 3] * rstd * sg[3]);
                *(u32x2*)(dst + dv) = w;
            }
    }
    __syncthreads();
}

constexpr int GM_ROW = 272;
DI void gmlp_item(const Params& p, unsigned char* smem, int item) {
    const int tid = threadIdx.x, lane = tid & 63, wid = tid >> 6, r = lane & 31, hh = lane >> 5;
    unsigned char* Wl = smem; unsigned char* XT = Wl + 128 * GM_ROW; float* st = (float*)(XT + 128 * GM_ROW);
    const int n = item & 15, g = (item >> 4) & 7, b = item >> 7;
    const int row0 = b * 2048 + n * 128;
    const bf16_t* gvb = (const bf16_t*)(p.ws + WS_BIG + BG_GVB);
    const bf16_t* ub = (const bf16_t*)(p.ws + WS_BIG + BG_U);
    bf16_t* mix = (bf16_t*)(p.ws + WS_BIG + BG_MIX0);
    if (tid < 128) {
        const u64_t* ls = (const u64_t*)(p.ws + WS_LNS) + 2 * (size_t)(row0 + tid);
        const float mean = fx_get(ls) * (1.f / 1024.f), var = fx_get(ls + 1) * (1.f / 1024.f) - mean * mean;
        st[2 * tid] = mean; st[2 * tid + 1] = rsqrtf(fmaxf(var, 0.f) + EPS);
    }
    {
        const f32x4* wsrc = (const f32x4*)(p.w_s + (size_t)g * 128 * 128);
#pragma unroll
        for (int i = 0; i < 8; ++i) { const int e = tid + 512 * i, pr = e >> 5, q4 = e & 31; const f32x4 w = wsrc[e]; u32x2 pk; pk.x = pk2(w[0], w[1]); pk.y = pk2(w[2], w[3]); *(u32x2*)(Wl + pr * GM_ROW + q4 * 8) = pk; }
    }
    __syncthreads();
    {
        const int c = tid & 127, qg = tid >> 7;
        const float lg = p.ln_g[g * 128 + c], lb = p.ln_b[g * 128 + c];
        const bf16_t* xp = gvb + (size_t)(row0 + 32 * qg) * 1024 + g * 128 + c;
#pragma unroll
        for (int q8 = 0; q8 < 4; ++q8) {
            float y[8];
#pragma unroll
            for (int j = 0; j < 8; ++j) { const int q = 32 * qg + 8 * q8 + j; const float xv = bf2f(xp[(size_t)(8 * q8 + j) * 1024]); y[j] = (xv - st[2 * q]) * st[2 * q + 1] * lg + lb; }
            *(u32x4*)(XT + c * GM_ROW + (32 * qg + 8 * q8) * 2) = pack8(y);
        }
    }
    __syncthreads();
    const int pt = wid >> 1, ct0 = (wid & 1) * 2;
    f32x16 acc[2];
#pragma unroll
    for (int i = 0; i < 16; ++i) { acc[0][i] = 0.f; acc[1][i] = 0.f; }
#pragma unroll
    for (int ks = 0; ks < 8; ++ks) {
        const bf16x8 a = *(const bf16x8*)(Wl + (32 * pt + r) * GM_ROW + (16 * ks + 8 * hh) * 2);
#pragma unroll
        for (int cc = 0; cc < 2; ++cc) { const bf16x8 xb = *(const bf16x8*)(XT + (32 * (ct0 + cc) + r) * GM_ROW + (16 * ks + 8 * hh) * 2); acc[cc] = MFMA32(a, xb, acc[cc]); }
    }
#pragma unroll
    for (int cc = 0; cc < 2; ++cc)
#pragma unroll
        for (int i = 0; i < 16; ++i) {
            const int prow = 32 * pt + (i & 3) + 8 * (i >> 2) + 4 * hh, c = 32 * (ct0 + cc) + r; const size_t row = (size_t)(row0 + prow);
            const float sv = acc[cc][i] + p.b_s[g * 128 + prow];
            mix[row * 2048 + 1024 + g * 128 + c] = f2bf(bf2f(ub[row * 1024 + g * 128 + c]) * sv);
        }
    __syncthreads();
}

constexpr int SC_QROW = 272, SC_KROW = 144;
constexpr int SC_QT = 0, SC_KT = 64 * SC_QROW, SC_KD = 2 * 64 * SC_QROW, SC_VT = SC_KD + 128 * SC_KROW, SC_EB = SC_VT + 128 * SC_KROW, SC_BUF = 73728, SC_TOT = 2 * SC_BUF;
struct ScanRaw { unsigned rq[8], rf[8], rv[8]; };
DI void sc_load_f(ScanRaw& R, const unsigned short* proj, int b, int hd, int dir, int c, int tg, int kp) {
#pragma unroll
    for (int i = 0; i < 8; ++i) {
        const int t = 64 * c + 8 * tg + i; const int pos = dir ? (2047 - t) : t;
        R.rf[i] = *(const unsigned*)(proj + (size_t)(b * 2048 + pos) * 10240 + hd * 128 + 2 * kp + 2048 * (1 + dir));
    }
}
DI void sc_load_qv(ScanRaw& R, const unsigned short* proj, int b, int hd, int dir, int c, int tg, int kp) {
#pragma unroll
    for (int i = 0; i < 8; ++i) {
        const int t = 64 * c + 8 * tg + i; const int pos = dir ? (2047 - t) : t;
        const unsigned short* rp = proj + (size_t)(b * 2048 + pos) * 10240 + hd * 128 + 2 * kp;
        R.rq[i] = *(const unsigned*)rp; R.rv[i] = *(const unsigned*)(rp + 6144);
    }
}
DI void sc_totals(const ScanRaw& R, float* TOT, int tg, int kp) {
    float s0 = 0.f, s1 = 0.f;
#pragma unroll
    for (int i = 0; i < 8; ++i) { s0 += h2f((unsigned short)(R.rf[i] & 0xffffu)); s1 += h2f((unsigned short)(R.rf[i] >> 16)); }
    *(f32x2*)(TOT + tg * 128 + 2 * kp) = (f32x2){s0, s1};
}
DI void sc_finalize(const ScanRaw& R, const float* TOT, unsigned char* buf, int tg, int kp) {
    unsigned char* QT = buf + SC_QT; unsigned char* KT = buf + SC_KT; unsigned char* KD = buf + SC_KD; unsigned char* VT = buf + SC_VT; float* EB = (float*)(buf + SC_EB);
    float off0 = 0.f, off1 = 0.f, all0 = 0.f, all1 = 0.f;
#pragma unroll
    for (int g = 0; g < 8; ++g) { const f32x2 tv = *(const f32x2*)(TOT + g * 128 + 2 * kp); all0 += tv[0]; all1 += tv[1]; if (g < tg) { off0 += tv[0]; off1 += tv[1]; } }
    const float ea0 = __expf(all0), ea1 = __expf(all1);
    if (tg == 0) *(f32x2*)(EB + 2 * kp) = (f32x2){ea0, ea1};
    unsigned kd0[4], kd1[4], vv0[4], vv1[4];
    float e0 = __expf(off0), e1 = __expf(off1), pd0 = 0.f, pd1 = 0.f;
#pragma unroll
    for (int i = 0; i < 8; ++i) {
        const float l0 = h2f((unsigned short)(R.rf[i] & 0xffffu)), l1 = h2f((unsigned short)(R.rf[i] >> 16));
        const float f0 = __expf(l0), f1 = __expf(l1);
        e0 *= f0; e1 *= f1;
        const float ie0 = __builtin_amdgcn_rcpf(e0), ie1 = __builtin_amdgcn_rcpf(e1);
        const float q0 = __uint_as_float(R.rq[i] << 16), q1 = __uint_as_float(R.rq[i] & 0xffff0000u);
        *(unsigned*)(QT + (8 * tg + i) * SC_QROW + kp * 4) = pk2(q0 * e0, q1 * e1);
        const float kt0 = (1.f - f0) * ie0, kt1 = (1.f - f1) * ie1;
        *(unsigned*)(KT + (8 * tg + i) * SC_QROW + kp * 4) = pk2(kt0, kt1);
        const float d0 = kt0 * ea0, d1 = kt1 * ea1;
        if (i & 1) { kd0[i >> 1] = pk2(pd0, d0); kd1[i >> 1] = pk2(pd1, d1); vv0[i >> 1] = (R.rv[i - 1] & 0xffffu) | (R.rv[i] << 16); vv1[i >> 1] = (R.rv[i - 1] >> 16) | (R.rv[i] & 0xffff0000u); }
        else { pd0 = d0; pd1 = d1; }
    }
    *(u32x4*)(KD + (2 * kp) * SC_KROW + tg * 16) = (u32x4){kd0[0], kd0[1], kd0[2], kd0[3]};
    *(u32x4*)(KD + (2 * kp + 1) * SC_KROW + tg * 16) = (u32x4){kd1[0], kd1[1], kd1[2], kd1[3]};
    *(u32x4*)(VT + (2 * kp) * SC_KROW + tg * 16) = (u32x4){vv0[0], vv0[1], vv0[2], vv0[3]};
    *(u32x4*)(VT + (2 * kp + 1) * SC_KROW + tg * 16) = (u32x4){vv1[0], vv1[1], vv1[2], vv1[3]};
}
DI void sc_mma(f32x16 (&st)[4], const unsigned char* buf, bf16_t* dst, int vt, int th, int r, int hh) {
    const unsigned char* QT = buf + SC_QT; const unsigned char* KT = buf + SC_KT; const unsigned char* KD = buf + SC_KD; const unsigned char* VT = buf + SC_VT; const float* EB = (const float*)(buf + SC_EB);
    f32x16 o;
#pragma unroll
    for (int i = 0; i < 16; ++i) o[i] = 0.f;
    {
        f32x16 Pd, Pl;
#pragma unroll
        for (int i = 0; i < 16; ++i) { Pd[i] = 0.f; Pl[i] = 0.f; }
#pragma unroll
        for (int ks = 0; ks < 8; ++ks) {
            const bf16x8 bq = *(const bf16x8*)(QT + (32 * th + r) * SC_QROW + (16 * ks + 8 * hh) * 2);
            const bf16x8 ad = *(const bf16x8*)(KT + (32 * th + r) * SC_QROW + (16 * ks + 8 * hh) * 2);
            Pd = MFMA32(ad, bq, Pd);
            if (th == 1) { const bf16x8 al = *(const bf16x8*)(KT + r * SC_QROW + (16 * ks + 8 * hh) * 2); Pl = MFMA32(al, bq, Pl); }
        }
#pragma unroll
        for (int i = 0; i < 16; ++i) { const int srow = (i & 3) + 8 * (i >> 2) + 4 * hh; if (srow > r) Pd[i] = 0.f; }
#pragma unroll
        for (int s2 = 0; s2 < 2; ++s2) {
            {
                u32x4 pw; pw.x = pk2(Pd[8 * s2], Pd[8 * s2 + 1]); pw.y = pk2(Pd[8 * s2 + 2], Pd[8 * s2 + 3]); pw.z = pk2(Pd[8 * s2 + 4], Pd[8 * s2 + 5]); pw.w = pk2(Pd[8 * s2 + 6], Pd[8 * s2 + 7]);
                const unsigned char* vp = VT + (32 * vt + r) * SC_KROW + (32 * th + 16 * s2 + 4 * hh) * 2;
                const u32x2 lo = *(const u32x2*)vp, hi = *(const u32x2*)(vp + 16); const u32x4 av = {lo.x, lo.y, hi.x, hi.y};
                o = MFMA32(__builtin_bit_cast(bf16x8, av), __builtin_bit_cast(bf16x8, pw), o);
            }
            if (th == 1) {
                u32x4 pw; pw.x = pk2(Pl[8 * s2], Pl[8 * s2 + 1]); pw.y = pk2(Pl[8 * s2 + 2], Pl[8 * s2 + 3]); pw.z = pk2(Pl[8 * s2 + 4], Pl[8 * s2 + 5]); pw.w = pk2(Pl[8 * s2 + 6], Pl[8 * s2 + 7]);
                const unsigned char* vp = VT + (32 * vt + r) * SC_KROW + (16 * s2 + 4 * hh) * 2;
                const u32x2 lo = *(const u32x2*)vp, hi = *(const u32x2*)(vp + 16); const u32x4 av = {lo.x, lo.y, hi.x, hi.y};
                o = MFMA32(__builtin_bit_cast(bf16x8, av), __builtin_bit_cast(bf16x8, pw), o);
            }
        }
    }
#pragma unroll
    for (int kt = 0; kt < 4; ++kt)
#pragma unroll
        for (int s2 = 0; s2 < 2; ++s2) {
            u32x4 sw; sw.x = pk2(st[kt][8 * s2], st[kt][8 * s2 + 1]); sw.y = pk2(st[kt][8 * s2 + 2], st[kt][8 * s2 + 3]); sw.z = pk2(st[kt][8 * s2 + 4], st[kt][8 * s2 + 5]); sw.w = pk2(st[kt][8 * s2 + 6], st[kt][8 * s2 + 7]);
            const unsigned char* qp = QT + (32 * th + r) * SC_QROW + (32 * kt + 16 * s2 + 4 * hh) * 2;
            const u32x2 lo = *(const u32x2*)qp, hi = *(const u32x2*)(qp + 16); const u32x4 qv = {lo.x, lo.y, hi.x, hi.y};
            o = MFMA32(__builtin_bit_cast(bf16x8, sw), __builtin_bit_cast(bf16x8, qv), o);
        }
#pragma unroll
    for (int g = 0; g < 4; ++g) { u32x2 w; w.x = pk2(o[4 * g], o[4 * g + 1]); w.y = pk2(o[4 * g + 2], o[4 * g + 3]); *(u32x2*)(dst + 8 * g) = w; }
    bf16x8 vbf[4];
#pragma unroll
    for (int ss = 0; ss < 4; ++ss) vbf[ss] = *(const bf16x8*)(VT + (32 * vt + r) * SC_KROW + (16 * ss + 8 * hh) * 2);
#pragma unroll
    for (int kt = 0; kt < 4; ++kt) {
#pragma unroll
        for (int g = 0; g < 4; ++g) { const f32x4 e = *(const f32x4*)(EB + 32 * kt + 8 * g + 4 * hh);
#pragma unroll
            for (int j = 0; j < 4; ++j) st[kt][4 * g + j] *= e[j]; }
#pragma unroll
        for (int ss = 0; ss < 4; ++ss) {
            const bf16x8 a = *(const bf16x8*)(KD + (32 * kt + r) * SC_KROW + (16 * ss + 8 * hh) * 2);
            st[kt] = MFMA32(a, vbf[ss], st[kt]);
        }
    }
}
#define SC_BARRIER() do { asm volatile("s_waitcnt lgkmcnt(0)" ::: "memory"); __builtin_amdgcn_s_barrier(); asm volatile("" ::: "memory"); } while (0)
DI void scan_mfma(const Params& p, unsigned char* smem) {
    const int tid = threadIdx.x, lane = tid & 63, wid = __builtin_amdgcn_readfirstlane(tid >> 6), r = lane & 31, hh = lane >> 5;
    const int vt = wid & 3, th = wid >> 2;
    const bool prep_first = (__builtin_popcount((unsigned)wid) & 1) != 0;
    unsigned char* buf0 = smem; unsigned char* buf1 = smem + SC_BUF; float* TOT0 = (float*)(smem + SC_TOT); float* TOT1 = TOT0 + 1024;
    const unsigned short* proj = (const unsigned short*)(p.ws + WS_BIG);
    bf16_t* o2 = (bf16_t*)(p.ws + WS_O2);
    const int kp = lane, tg = wid;
    for (int item = blockIdx.x; item < 128; item += gridDim.x) {
        const int hd = item & 15, b = (item >> 4) & 3, dir = item >> 6;
        f32x16 st[4];
#pragma unroll
        for (int kt = 0; kt < 4; ++kt)
#pragma unroll
            for (int i = 0; i < 16; ++i) st[kt][i] = 0.f;
        bf16_t* obase = o2 + (size_t)dir * MROWS * DM + (size_t)(b * 2048) * 2048 + hd * 128 + 32 * vt + 4 * hh;
#define SC_DST(c) (obase + (size_t)(dir ? (2047 - (64 * (c) + 32 * th + r)) : (64 * (c) + 32 * th + r)) * 2048)
        ScanRaw R1, R2;
        sc_load_f(R1, proj, b, hd, dir, 0, tg, kp); sc_load_qv(R1, proj, b, hd, dir, 0, tg, kp); sc_load_f(R2, proj, b, hd, dir, 1, tg, kp);
        sc_totals(R1, TOT0, tg, kp); sc_totals(R2, TOT1, tg, kp);
        SC_BARRIER();
        sc_finalize(R1, TOT0, buf0, tg, kp);
#pragma unroll
        for (int i = 0; i < 8; ++i) R1.rf[i] = R2.rf[i];
        sc_load_qv(R1, proj, b, hd, dir, 1, tg, kp);
        SC_BARRIER();
        if (wid >= 4) __builtin_amdgcn_s_setprio(1);
#pragma clang loop unroll(disable)
        for (int c = 0; c < 32; ++c) {
            unsigned char* bufc = (c & 1) ? buf1 : buf0; unsigned char* bufn = (c & 1) ? buf0 : buf1;
            float* TOTn = (c & 1) ? TOT0 : TOT1; float* TOTnn = (c & 1) ? TOT1 : TOT0;
            if (c + 2 < 32) sc_load_f(R2, proj, b, hd, dir, c + 2, tg, kp);
            if (prep_first && c + 1 < 32) sc_finalize(R1, TOTn, bufn, tg, kp);
            sc_mma(st, bufc, SC_DST(c), vt, th, r, hh);
            if (!prep_first && c + 1 < 32) sc_finalize(R1, TOTn, bufn, tg, kp);
            if (c + 2 < 32) {
                sc_totals(R2, TOTnn, tg, kp);
#pragma unroll
                for (int i = 0; i < 8; ++i) R1.rf[i] = R2.rf[i];
                sc_load_qv(R1, proj, b, hd, dir, c + 2, tg, kp);
            }
            SC_BARRIER();
        }
        __builtin_amdgcn_s_setprio(0);
#undef SC_DST
    }
}

struct ScanRaw16 { unsigned rq[16], rf[16], rv[16]; };
DI void sp_load_f(ScanRaw16& R, const unsigned short* proj, int b, int hd, int dir, int c, int tg, int kp) {
#pragma unroll
    for (int i = 0; i < 16; ++i) {
        const int t = 64 * c + 16 * tg + i; const int pos = dir ? (2047 - t) : t;
        R.rf[i] = *(const unsigned*)(proj + (size_t)(b * 2048 + pos) * 10240 + hd * 128 + 2 * kp + 2048 * (1 + dir));
    }
}
DI void sp_load_qv(ScanRaw16& R, const unsigned short* proj, int b, int hd, int dir, int c, int tg, int kp) {
#pragma unroll
    for (int i = 0; i < 16; ++i) {
        const int t = 64 * c + 16 * tg + i; const int pos = dir ? (2047 - t) : t;
        const unsigned short* rp = proj + (size_t)(b * 2048 + pos) * 10240 + hd * 128 + 2 * kp;
        R.rq[i] = *(const unsigned*)rp; R.rv[i] = *(const unsigned*)(rp + 6144);
    }
}
DI void sp_totals(const unsigned (&rf)[16], float* TOT, int tg, int kp) {
    float s0 = 0.f, s1 = 0.f;
#pragma unroll
    for (int i = 0; i < 16; ++i) { s0 += h2f((unsigned short)(rf[i] & 0xffffu)); s1 += h2f((unsigned short)(rf[i] >> 16)); }
    *(f32x2*)(TOT + tg * 128 + 2 * kp) = (f32x2){s0, s1};
}
DI void sp_finalize(const ScanRaw16& R, const float* TOT, unsigned char* buf, int tg, int kp) {
    unsigned char* QT = buf + SC_QT; unsigned char* KT = buf + SC_KT; unsigned char* KD = buf + SC_KD; unsigned char* VT = buf + SC_VT; float* EB = (float*)(buf + SC_EB);
    float off0 = 0.f, off1 = 0.f, all0 = 0.f, all1 = 0.f;
#pragma unroll
    for (int g = 0; g < 4; ++g) { const f32x2 tv = *(const f32x2*)(TOT + g * 128 + 2 * kp); all0 += tv[0]; all1 += tv[1]; if (g < tg) { off0 += tv[0]; off1 += tv[1]; } }
    const float ea0 = __builtin_amdgcn_exp2f(all0), ea1 = __builtin_amdgcn_exp2f(all1);
    if (tg == 0) *(f32x2*)(EB + 2 * kp) = (f32x2){ea0, ea1};
    unsigned kd0[8], kd1[8], vv0[8], vv1[8];
    float e0 = __builtin_amdgcn_exp2f(off0), e1 = __builtin_amdgcn_exp2f(off1), pd0 = 0.f, pd1 = 0.f;
#pragma unroll
    for (int i = 0; i < 16; ++i) {
        const float l0 = h2f((unsigned short)(R.rf[i] & 0xffffu)), l1 = h2f((unsigned short)(R.rf[i] >> 16));
        const float f0 = __builtin_amdgcn_exp2f(l0), f1 = __builtin_amdgcn_exp2f(l1);
        e0 *= f0; e1 *= f1;
        const float ie0 = __builtin_amdgcn_rcpf(e0), ie1 = __builtin_amdgcn_rcpf(e1);
        const float q0 = __uint_as_float(R.rq[i] << 16), q1 = __uint_as_float(R.rq[i] & 0xffff0000u);
        *(unsigned*)(QT + (16 * tg + i) * SC_QROW + kp * 4) = pk2(q0 * e0, q1 * e1);
        const float kt0 = (1.f - f0) * ie0, kt1 = (1.f - f1) * ie1;
        *(unsigned*)(KT + (16 * tg + i) * SC_QROW + kp * 4) = pk2(kt0, kt1);
        const float d0 = kt0 * ea0, d1 = kt1 * ea1;
        if (i & 1) { kd0[i >> 1] = pk2(pd0, d0); kd1[i >> 1] = pk2(pd1, d1); vv0[i >> 1] = (R.rv[i - 1] & 0xffffu) | (R.rv[i] << 16); vv1[i >> 1] = (R.rv[i - 1] >> 16) | (R.rv[i] & 0xffff0000u); }
        else { pd0 = d0; pd1 = d1; }
    }
#pragma unroll
    for (int q = 0; q < 2; ++q) {
        *(u32x4*)(KD + (2 * kp) * SC_KROW + tg * 32 + q * 16) = (u32x4){kd0[4 * q], kd0[4 * q + 1], kd0[4 * q + 2], kd0[4 * q + 3]};
        *(u32x4*)(KD + (2 * kp + 1) * SC_KROW + tg * 32 + q * 16) = (u32x4){kd1[4 * q], kd1[4 * q + 1], kd1[4 * q + 2], kd1[4 * q + 3]};
        *(u32x4*)(VT + (2 * kp) * SC_KROW + tg * 32 + q * 16) = (u32x4){vv0[4 * q], vv0[4 * q + 1], vv0[4 * q + 2], vv0[4 * q + 3]};
        *(u32x4*)(VT + (2 * kp + 1) * SC_KROW + tg * 32 + q * 16) = (u32x4){vv1[4 * q], vv1[4 * q + 1], vv1[4 * q + 2], vv1[4 * q + 3]};
    }
}
DI void scan_pc(const Params& p, unsigned char* smem) {
    const int tid = threadIdx.x, lane = tid & 63, wid = __builtin_amdgcn_readfirstlane(tid >> 6), r = lane & 31, hh = lane >> 5;
    const bool producer = (__builtin_popcount((unsigned)wid) & 1) != 0;
    const int role = wid >> 1;
    unsigned char* buf0 = smem; unsigned char* buf1 = smem + SC_BUF; float* TOT0 = (float*)(smem + SC_TOT); float* TOT1 = TOT0 + 1024;
    const unsigned short* proj = (const unsigned short*)(p.ws + WS_BIG);
    bf16_t* o2 = (bf16_t*)(p.ws + WS_O2);
    for (int it = blockIdx.x; it < 256; it += gridDim.x) {
        int item = it;
        if (gridDim.x == 256) { const int xcd = it & 7, slot = it >> 3; item = (((slot >> 1) << 3) + xcd) * 2 + (slot & 1); }
        const int vh = item & 1, hd = (item >> 1) & 15, b = (item >> 5) & 3, dir = item >> 7;
        if (producer) {
            const int tg = role, kp = lane;
            ScanRaw16 RA, RB;
            sp_load_f(RB, proj, b, hd, dir, 0, tg, kp); sp_load_qv(RB, proj, b, hd, dir, 0, tg, kp);
            sp_load_f(RA, proj, b, hd, dir, 1, tg, kp); sp_load_qv(RA, proj, b, hd, dir, 1, tg, kp);
            sp_totals(RB.rf, TOT0, tg, kp); sp_totals(RA.rf, TOT1, tg, kp);
            SC_BARRIER();
            sp_finalize(RB, TOT0, buf0, tg, kp);
            sp_load_f(RB, proj, b, hd, dir, 2, tg, kp); sp_load_qv(RB, proj, b, hd, dir, 2, tg, kp);
            SC_BARRIER();
#pragma clang loop unroll(disable)
            for (int c = 0; c < 32; c += 2) {
                sp_finalize(RA, TOT1, buf1, tg, kp);
                if (c + 3 < 32) { sp_load_f(RA, proj, b, hd, dir, c + 3, tg, kp); sp_load_qv(RA, proj, b, hd, dir, c + 3, tg, kp); }
                if (c + 2 < 32) sp_totals(RB.rf, TOT0, tg, kp);
                SC_BARRIER();
                if (c + 2 < 32) sp_finalize(RB, TOT0, buf0, tg, kp);
                if (c + 4 < 32) { sp_load_f(RB, proj, b, hd, dir, c + 4, tg, kp); sp_load_qv(RB, proj, b, hd, dir, c + 4, tg, kp); }
                if (c + 3 < 32) sp_totals(RA.rf, TOT1, tg, kp);
                SC_BARRIER();
            }
        } else {
            const int vt = 2 * vh + (role & 1), th = role >> 1;
            f32x16 st[4];
#pragma unroll
            for (int kt = 0; kt < 4; ++kt)
#pragma unroll
                for (int i = 0; i < 16; ++i) st[kt][i] = 0.f;
            bf16_t* obase = o2 + (size_t)dir * MROWS * DM + (size_t)(b * 2048) * 2048 + hd * 128 + 32 * vt + 4 * hh;
            SC_BARRIER();
            SC_BARRIER();
#pragma clang loop unroll(disable)
            for (int c = 0; c < 32; ++c) {
                const unsigned char* bufc = (c & 1) ? buf1 : buf0;
                const int t = 64 * c + 32 * th + r;
                sc_mma(st, bufc, obase + (size_t)(dir ? (2047 - t) : t) * 2048, vt, th, r, hh);
                SC_BARRIER();
            }
        }
    }
}

DI void postscan_phase(const Params& p) {
    const int lane = threadIdx.x & 63, wid = threadIdx.x >> 6, stride = gridDim.x * 8;
    const bf16_t* o2 = (const bf16_t*)(p.ws + WS_O2);
    const bf16_t* proj = (const bf16_t*)(p.ws + WS_BIG);
    bf16_t* mix = (bf16_t*)(p.ws + WS_H);
    f32x4 gn[4][2];
#pragma unroll
    for (int i = 0; i < 4; ++i) { const float* gp = p.g_norm + (lane + 64 * i) * 8; gn[i][0] = *(const f32x4*)gp; gn[i][1] = *(const f32x4*)(gp + 4); }
    u32x4 fA[4], bA[4], sA[4], fB[4], bB[4], sB[4];
#define PS_LOAD(f, bw, s, row_) do { _Pragma("unroll") for (int i = 0; i < 4; ++i) { const int col = (lane + 64 * i) * 8; \
        (f)[i] = *(const u32x4*)(o2 + (size_t)(row_) * DM + col); (bw)[i] = *(const u32x4*)(o2 + (size_t)MROWS * DM + (size_t)(row_) * DM + col); \
        (s)[i] = *(const u32x4*)(proj + (size_t)(row_) * 10240 + 8192 + col); } } while (0)
#define PS_DO(f, bw, s, row_) do { float v[4][8]; float ss = 0.f; \
        _Pragma("unroll") for (int i = 0; i < 4; ++i) { float a[8], bb[8]; unpack8((f)[i], a); unpack8((bw)[i], bb); \
            _Pragma("unroll") for (int j = 0; j < 8; ++j) { v[i][j] = a[j] + bb[j]; ss += v[i][j] * v[i][j]; } } \
        ss = wave_sum(ss); const float rstd = rsqrtf(ss * (1.f / DM) + EPS); \
        _Pragma("unroll") for (int i = 0; i < 4; ++i) { float sg[8], y[8]; unpack8((s)[i], sg); \
            _Pragma("unroll") for (int j = 0; j < 8; ++j) y[j] = v[i][j] * rstd * gn[i][j >> 2][j & 3] * sg[j]; \
            *(u32x4*)(mix + (size_t)(row_) * DM + (lane + 64 * i) * 8) = pack8(y); } } while (0)
    int row = blockIdx.x * 8 + wid;
    if (row < MROWS) PS_LOAD(fA, bA, sA, row);
    for (; row < MROWS; row += 2 * stride) {
        if (row + stride < MROWS) PS_LOAD(fB, bB, sB, row + stride);
        PS_DO(fA, bA, sA, row);
        if (row + stride < MROWS) {
            if (row + 2 * stride < MROWS) PS_LOAD(fA, bA, sA, row + 2 * stride);
            PS_DO(fB, bB, sB, row + stride);
        }
    }
#undef PS_LOAD
#undef PS_DO
}

#define XB_TMO      128
#define XB_XCNT(j)  (256  + 64 * (j))
#define XB_XSUB(j)  (1280 + 64 * (j))
#define XB_XGEN(j)  (2304 + 64 * (j))
#define XB_TOP      3328
#define XB_TOPGEN   3392
#define XCD_BAR_WORDS 3456
#define XB_SPIN_CAP (1u << 20)
DI unsigned xb_ld(unsigned* p)              { return __hip_atomic_load(p, __ATOMIC_RELAXED, __HIP_MEMORY_SCOPE_AGENT); }
DI unsigned xb_add(unsigned* p, unsigned v) { return __hip_atomic_fetch_add(p, v, __ATOMIC_RELAXED, __HIP_MEMORY_SCOPE_AGENT); }
DI unsigned xb_xcc_id() { return (unsigned)__builtin_amdgcn_s_getreg((3 << 11) | 20) & 0xFu; }
#define XB_SPIN(cond, bar) do { unsigned _sp = 0; while (cond) { __builtin_amdgcn_s_sleep(1); \
    if ((++_sp & 255u) == 0u) { if (xb_ld(&(bar)[XB_TMO])) break; if (_sp > XB_SPIN_CAP) { atomicAdd(&(bar)[XB_TMO], 1u); break; } } } } while (0)
struct XcdBarrier { unsigned* bar; unsigned x; volatile LAS unsigned* st; };
DI XcdBarrier xcd_barrier_post(unsigned* bar, volatile LAS unsigned* st) {
    XcdBarrier b; b.bar = bar; b.x = xb_xcc_id(); b.st = st;
    if (threadIdx.x == 0) (void)xb_add(&bar[XB_XCNT(b.x)], 1u);
    return b;
}
DI void xcd_barrier_complete(unsigned* bar, unsigned x, unsigned& nloc, unsigned& nx) {
    const unsigned G = gridDim.x * gridDim.y * gridDim.z;
    unsigned sum, cnt, mine, sp = 0u;
    for (;;) {
        sum = 0u; cnt = 0u; mine = 0u;
#pragma unroll
        for (unsigned j = 0; j < 16; ++j) { const unsigned c = xb_ld(&bar[XB_XCNT(j)]); sum += c; cnt += (c > 0u) ? 1u : 0u; mine = (j == x) ? c : mine; }
        if (sum == G) break;
        __builtin_amdgcn_s_sleep(1);
        if ((++sp & 255u) == 0u) { if (xb_ld(&bar[XB_TMO])) break; if (sp > XB_SPIN_CAP) { atomicAdd(&bar[XB_TMO], 1u); break; } }
    }
    nloc = mine > 0u ? mine : 1u; nx = cnt > 0u ? cnt : 1u;
}
DI void xcd_barrier(const XcdBarrier& b) {
    asm volatile("s_waitcnt vmcnt(0)" ::: "memory");
    __syncthreads();
    if (threadIdx.x == 0) {
        unsigned* bar = b.bar;
        __builtin_amdgcn_s_waitcnt(0);
        unsigned nloc = b.st[0], nx = b.st[1];
        if (nloc == 0u) { xcd_barrier_complete(bar, b.x, nloc, nx); b.st[0] = nloc; b.st[1] = nx; }
        const unsigned old = xb_add(&bar[XB_XSUB(b.x)], 1u);
        const unsigned gen = old / nloc;
        if (old + 1u == (gen + 1u) * nloc) {
            __builtin_amdgcn_fence(__ATOMIC_RELEASE, "agent");
            asm volatile("s_waitcnt vmcnt(0)" ::: "memory");
            const unsigned og = xb_add(&bar[XB_TOP], 1u);
            const unsigned tg = og / nx;
            if (og + 1u == (tg + 1u) * nx) xb_add(&bar[XB_TOPGEN], 1u);
            else XB_SPIN(xb_ld(&bar[XB_TOPGEN]) == tg, bar);
            __builtin_amdgcn_fence(__ATOMIC_ACQUIRE, "agent");
            xb_add(&bar[XB_XGEN(b.x)], 1u);
            asm volatile("s_waitcnt vmcnt(0)" ::: "memory");
        } else {
            XB_SPIN(xb_ld(&bar[XB_XGEN(b.x)]) == gen, bar);
            __builtin_amdgcn_fence(__ATOMIC_ACQUIRE, "agent");
            asm volatile("s_waitcnt vmcnt(0)" ::: "memory");
        }
    }
    __syncthreads();
}

__global__ void __launch_bounds__(512, 2) mega(Params p, int ph_lo, int ph_hi) {
    extern __shared__ __attribute__((aligned(16))) unsigned char smem[];
    cg::grid_group grid = cg::this_grid();
    unsigned char* ws = p.ws;
    LAS unsigned char* lds = (LAS unsigned char*)smem;
    float* h = (float*)(ws + WS_H);
    bf16_t* hn = (bf16_t*)(ws + WS_HN);
    volatile LAS unsigned* xst = (volatile LAS unsigned*)(lds + LDS_BYTES - 16);
    if (threadIdx.x == 0) { xst[0] = 0u; xst[1] = 0u; }
    __syncthreads();
    const XcdBarrier xbar = xcd_barrier_post((unsigned*)(ws + WS_BAR), xst);
    if (ph_lo > 0) grid.sync();
#define SEAM(k) xcd_barrier(xbar)
#ifndef ONLY_PH
#define ONLY_PH -1
#endif
#ifndef DUP_MASK
#define DUP_MASK 0
#endif
#define PH_BEGIN(k) if ((ONLY_PH < 0 || ONLY_PH == (k)) && ph_lo <= (k) && (k) < ph_hi) { for (int rep_ = 0; rep_ <= ((DUP_MASK >> (k)) & 1); ++rep_) {
#define PH_END(k) if (rep_ < ((DUP_MASK >> (k)) & 1)) xcd_barrier(xbar); } if ((k) + 1 < ph_hi) SEAM(k); }
    PH_BEGIN(0) phase0(p, smem); PH_END(0)
    PH_BEGIN(1) { EpiIn0 E{(bf16_t*)(ws + WS_BIG + BG_QK), (bf16_t*)(ws + WS_BIG + BG_VT), (bf16_t*)(ws + WS_BIG + BG_U), (bf16_t*)(ws + WS_BIG + BG_GVB), (const float*)(ws + WS_TAB), (u64_t*)(ws + WS_LNS)};
                  pg8::gemm_phase(lds, hn, (const bf16_t*)(ws + WS_IN0), MROWS, 5120, 2048, E);
                  int sid, ns; if (gemm_short_block(MROWS, 5120, sid, ns)) {
                      cvt_tiles(sid, ns, (float*)smem, p.even_w_out, nullptr, (bf16_t*)(ws + WS_OUT0), 2048, 2048, 2048, 0, nullptr);
                      cvt_tiles(sid, ns, (float*)smem, p.w_gate, p.w_up, (bf16_t*)(ws + WS_GU0), 2048, FFN, 2 * FFN, 2, p.ffn_norm); } } PH_END(1)
    PH_BEGIN(2) {
            float lam;
            { const int lane = threadIdx.x & 63; const float a = wave_sum(p.lq1[lane] * p.lk1[lane]), bq = wave_sum(p.lq2[lane] * p.lk2[lane]); lam = expf(a) - expf(bq) + 0.2f; }
#ifndef DUP_ATT
#define DUP_ATT 0
#endif
#ifndef DUP_GMLP
#define DUP_GMLP 0
#endif
            for (int rep2 = 0; rep2 <= DUP_ATT; ++rep2) for (int it = blockIdx.x; it < 512; it += gridDim.x) {
                int item = it;
                if (gridDim.x == 256) {
                    const int xcd = blockIdx.x & 7, j = (it >> 8) * 32 + (blockIdx.x >> 3);
                    item = (xcd * 4 + (j >> 4)) * 16 + (j & 15);
                }
                attn_item(p, smem, item, lam);
            }
            for (int rep2 = 0; rep2 <= DUP_GMLP; ++rep2) for (int item = blockIdx.x; item < 512; item += gridDim.x) gmlp_item(p, smem, item);
    } PH_END(2)
    PH_BEGIN(3) { EpiResN<true> E{p.x, hn, (u64_t*)(ws + WS_SSQ)}; pg8::gemm_phase(lds, (const bf16_t*)(ws + WS_BIG + BG_MIX0), (const bf16_t*)(ws + WS_OUT0), MROWS, 2048, 2048, E); } PH_END(3)
    PH_BEGIN(5) { EpiGU E{(bf16_t*)(ws + WS_BIG), (const u64_t*)(ws + WS_SSQ)}; pg8::gemm_phase(lds, hn, (const bf16_t*)(ws + WS_GU0), MROWS, 2 * FFN, 2048, E);
                  int sid, ns; if (gemm_short_block(MROWS, 2 * FFN, sid, ns)) { cvt_tiles(sid, ns, (float*)smem, p.w_down, nullptr, (bf16_t*)(ws + WS_DN0), FFN, 2048, 2048, 0, nullptr);
                      cvt_tiles(sid, ns, (float*)smem, p.hgrn_w_in, nullptr, (bf16_t*)(ws + WS_IN1), 2048, 10240, 10240, 0, p.mix_norm + DM); } } PH_END(5)
    PH_BEGIN(6) { EpiResN<false> E{hn, hn, (u64_t*)(ws + WS_SSQ) + 8192}; pg8::gemm_phase(lds, (const bf16_t*)(ws + WS_BIG), (const bf16_t*)(ws + WS_DN0), MROWS, 2048, FFN, E); } PH_END(6)
    PH_BEGIN(8) { EpiIn1 E{(unsigned short*)(ws + WS_BIG), (const float*)(ws + WS_TAB) + 2048 * 16, (const u64_t*)(ws + WS_SSQ) + 8192}; pg8::gemm_phase(lds, hn, (const bf16_t*)(ws + WS_IN1), MROWS, 10240, 2048, E); } PH_END(8)
    PH_BEGIN(9) {
        scan_pc(p, smem);
        __syncthreads();
        const bool conv = true; const int sid = (int)blockIdx.x, ns = (int)gridDim.x;
        if (conv) {
            cvt_tiles(sid, ns, (float*)smem, p.hgrn_w_out, nullptr, (bf16_t*)(ws + WS_OUT1), 2048, 2048, 2048, 0, nullptr);
            cvt_tiles(sid, ns, (float*)smem, p.w_gate + (size_t)DM * FFN, p.w_up + (size_t)DM * FFN, (bf16_t*)(ws + WS_GU1), 2048, FFN, 2 * FFN, 2, p.ffn_norm + DM);
        }
    } PH_END(9)
    PH_BEGIN(10) postscan_phase(p); PH_END(10)
    PH_BEGIN(11) { EpiResN<false> E{hn, hn, (u64_t*)(ws + WS_SSQ) + 16384}; pg8::gemm_phase(lds, (const bf16_t*)(ws + WS_H), (const bf16_t*)(ws + WS_OUT1), MROWS, 2048, 2048, E); } PH_END(11)
    PH_BEGIN(13) { EpiGU E{(bf16_t*)(ws + WS_BIG), (const u64_t*)(ws + WS_SSQ) + 16384}; pg8::gemm_phase(lds, hn, (const bf16_t*)(ws + WS_GU1), MROWS, 2 * FFN, 2048, E);
                   int sid, ns; if (gemm_short_block(MROWS, 2 * FFN, sid, ns)) cvt_tiles(sid, ns, (float*)smem, p.w_down + (size_t)DM * FFN, nullptr, (bf16_t*)(ws + WS_DN1), FFN, 2048, 2048, 0, nullptr); } PH_END(13)
    if (ph_lo <= 14 && 14 < ph_hi) {
        if (gridDim.x == 256) {
            EpiFinal E{hn, p.out, p.final_norm, (u64_t*)(ws + WS_SSQ3), (unsigned*)(ws + WS_CNT)};
            pg8::gemm_phase(lds, (const bf16_t*)(ws + WS_BIG), (const bf16_t*)(ws + WS_DN1), MROWS, 2048, FFN, E);
        } else {
            { EpiResB E{hn, h}; pg8::gemm_phase(lds, (const bf16_t*)(ws + WS_BIG), (const bf16_t*)(ws + WS_DN1), MROWS, 2048, FFN, E); }
            xcd_barrier(xbar);
            rmsnorm_phase<false>(h, p.final_norm, p.out, (int)(((long)MROWS * blockIdx.x) / gridDim.x), (int)(((long)MROWS * (blockIdx.x + 1)) / gridDim.x));
        }
    }
}

extern "C" void kernel_launch(void* const* d_in, const int* in_sizes, int n_in, void* d_out, int out_size, void* d_ws, size_t ws_size, hipStream_t stream) {
    static int grid_blocks = 0;
    if (!grid_blocks) {
        int dev = 0, cus = 0, per_cu = 0;
        hipGetDevice(&dev);
        hipDeviceGetAttribute(&cus, hipDeviceAttributeMultiprocessorCount, dev);
        hipFuncSetAttribute((const void*)mega, hipFuncAttributeMaxDynamicSharedMemorySize, LDS_BYTES);
        hipOccupancyMaxActiveBlocksPerMultiprocessor(&per_cu, (const void*)mega, 512, LDS_BYTES);
        if (per_cu < 1) { fprintf(stderr, "kernel_launch: occupancy query reports %d blocks per CU\n", per_cu); per_cu = 1; }
        grid_blocks = cus * per_cu;
        if (ws_size < WS_END) fprintf(stderr, "kernel_launch: workspace too small: %zu < %zu\n", ws_size, (size_t)WS_END);
    }
    if (hipMemsetAsync((unsigned char*)d_ws + WS_BAR, 0, 3456 * 4, stream) != hipSuccess) fprintf(stderr, "kernel_launch: memset of barrier words failed\n");
    Params p{};
    const float** pp = (const float**)&p;
    for (int i = 0; i < 22; ++i) pp[i] = (const float*)d_in[i];
    p.out = (float*)d_out; p.ws = (unsigned char*)d_ws;
    int lo = 0, hi = 16;
    void* args[] = {&p, &lo, &hi};
    hipError_t e = hipLaunchCooperativeKernel((const void*)mega, dim3(grid_blocks), dim3(512), args, LDS_BYTES, stream);
    if (e != hipSuccess) fprintf(stderr, "cooperative launch failed: %s (grid %d)\n", hipGetErrorString(e), grid_blocks);
}
```
